# Optimizing an MI355X kernel written in HIP

```python
import jax, jax.numpy as jnp
from jax import lax
import numpy as np

D_MODEL = 1024
BATCH = 16
SEQ = 2048
DEPTH = 2

N_Q_HEADS = 8
N_KV_HEADS = 2
HEAD_DIM = 64
Q_GROUP = N_Q_HEADS // N_KV_HEADS
ATT_WIDTH = N_Q_HEADS * HEAD_DIM
KV_WIDTH = N_KV_HEADS * HEAD_DIM
WINDOW = 128
ATT_BLOCK = 128
SGU_WIDTH = D_MODEL // 2
SGU_GROUPS = 8
SGU_GROUP_DIM = SGU_WIDTH // SGU_GROUPS
SGU_CHUNK = 128
N_BRANCHES = 2
IN_WIDTH = ATT_WIDTH + 2 * KV_WIDTH + 2 * SGU_WIDTH + N_BRANCHES * D_MODEL
D_FF = 256 * ((8 * D_MODEL // 3 + 255) // 256)
CONV_WIDTH = 3
NORM_EPS = 1e-6
NEG_INF = -1e30

kernel_name = "hybrid_gated_swa_sgu_convffn"


def rmsnorm(x, gain):
    xf = x.astype(jnp.float32)
    y = xf * lax.rsqrt(jnp.mean(xf * xf, axis=-1, keepdims=True) + NORM_EPS)
    return (y * gain.astype(jnp.float32)).astype(x.dtype)


def alibi_slopes():
    return jnp.exp2(-8.0 * (jnp.arange(N_Q_HEADS, dtype=jnp.float32) + 1.0) / N_Q_HEADS)


def sliding_window_attention(q, k, v, q_gain, k_gain, sinks):
    B, S, _ = q.shape
    nb = S // ATT_BLOCK
    q = rmsnorm(q.reshape(B, S, N_Q_HEADS, HEAD_DIM), q_gain)
    k = rmsnorm(k.reshape(B, S, N_KV_HEADS, HEAD_DIM), k_gain)
    v = v.reshape(B, S, N_KV_HEADS, HEAD_DIM)
    qb = q.reshape(B, nb, ATT_BLOCK, N_KV_HEADS, Q_GROUP, HEAD_DIM)

    def band(t):
        tp = jnp.pad(t, ((0, 0), (ATT_BLOCK, 0), (0, 0), (0, 0)))
        tp = tp.reshape(B, nb + 1, ATT_BLOCK, N_KV_HEADS, HEAD_DIM)
        return jnp.concatenate([tp[:, :-1], tp[:, 1:]], axis=2)

    kb, vb = band(k), band(v)
    scores = jnp.einsum('bnqhgd,bnkhd->bnhgqk', qb, kb,
                        preferred_element_type=jnp.float32) * (HEAD_DIM ** -0.5)
    qi = jnp.arange(ATT_BLOCK)[:, None]
    kj = jnp.arange(2 * ATT_BLOCK)[None, :]
    dist = qi + ATT_BLOCK - kj
    key_pos = jnp.arange(nb)[:, None] * ATT_BLOCK - ATT_BLOCK + kj
    valid = ((dist >= 0) & (dist < WINDOW))[None] & (key_pos >= 0)[:, None, :]
    slopes = alibi_slopes().reshape(N_KV_HEADS, Q_GROUP)
    alibi = -slopes[:, :, None, None] * dist.astype(jnp.float32)[None, None]
    scores = jnp.where(valid[None, :, None, None], scores + alibi[None, None], NEG_INF)
    sink = jnp.broadcast_to(
        sinks.astype(jnp.float32).reshape(1, 1, N_KV_HEADS, Q_GROUP, 1, 1),
        scores.shape[:-1] + (1,))
    probs = jax.nn.softmax(jnp.concatenate([scores, sink], axis=-1), axis=-1)[..., :-1]
    out = jnp.einsum('bnhgqk,bnkhd->bnqhgd', probs.astype(v.dtype), vb)
    return out.reshape(B, S, ATT_WIDTH)


def chunked_spatial_gating(u, v, sgu_gain, w_s, b_s):
    B, S, _ = u.shape
    nc = S // SGU_CHUNK
    u = jax.nn.gelu(u)
    v = rmsnorm(jax.nn.gelu(v), sgu_gain)
    vc = v.reshape(B, nc, SGU_CHUNK, SGU_GROUPS, SGU_GROUP_DIM)
    causal = jnp.tril(jnp.ones((SGU_CHUNK, SGU_CHUNK), dtype=bool))
    w = jnp.where(causal[None], w_s, 0)
    mixed = jnp.einsum('gij,bcjgd->bcigd', w, vc) + b_s.T[:, :, None]
    return u * mixed.reshape(B, S, SGU_WIDTH)


def conv_gated_mlp(h, w_up, conv_w, conv_b, w_down):
    S = h.shape[1]
    z = h @ w_up
    zp = jnp.pad(z, ((0, 0), (CONV_WIDTH - 1, 0), (0, 0)))
    zc = conv_b
    for tap in range(CONV_WIDTH):
        zc = zc + conv_w[tap] * zp[:, tap:tap + S]
    gate, val = jnp.split(zc, 2, axis=-1)
    return (jax.nn.silu(gate) * val) @ w_down


def setup_inputs(seed: int = 0) -> dict:
    key = jax.random.key(seed)
    ks = jax.random.split(key, 20)
    f32 = jnp.float32

    def nrm(k, shape, scale):
        return jax.random.normal(k, shape, f32) * scale

    return {
        "x": nrm(ks[0], (BATCH, SEQ, D_MODEL), 1.0),
        "mix_norm": 1.0 + nrm(ks[1], (DEPTH, D_MODEL), 0.05),
        "w_in": nrm(ks[2], (DEPTH, D_MODEL, IN_WIDTH), D_MODEL ** -0.5),
        "q_norm": 1.0 + nrm(ks[3], (DEPTH, HEAD_DIM), 0.05),
        "k_norm": 1.0 + nrm(ks[4], (DEPTH, HEAD_DIM), 0.05),
        "sinks": nrm(ks[5], (DEPTH, N_Q_HEADS), 0.5),
        "sgu_norm": 1.0 + nrm(ks[6], (DEPTH, SGU_WIDTH), 0.05),
        "w_s": nrm(ks[7], (DEPTH, SGU_GROUPS, SGU_CHUNK, SGU_CHUNK), SGU_CHUNK ** -0.5),
        "b_s": 1.0 + nrm(ks[8], (DEPTH, SGU_GROUPS, SGU_CHUNK), 0.1),
        "w_oa": nrm(ks[9], (DEPTH, ATT_WIDTH, D_MODEL), ATT_WIDTH ** -0.5),
        "w_ob": nrm(ks[10], (DEPTH, SGU_WIDTH, D_MODEL), SGU_WIDTH ** -0.5),
        "w_out": nrm(ks[11], (DEPTH, D_MODEL, D_MODEL), D_MODEL ** -0.5),
        "ffn_norm": 1.0 + nrm(ks[12], (DEPTH, D_MODEL), 0.05),
        "w_up": nrm(ks[13], (DEPTH, D_MODEL, 2 * D_FF), D_MODEL ** -0.5),
        "conv_w": nrm(ks[14], (DEPTH, CONV_WIDTH, 2 * D_FF), CONV_WIDTH ** -0.5),
        "conv_b": nrm(ks[15], (DEPTH, 2 * D_FF), 0.02),
        "w_down": nrm(ks[16], (DEPTH, D_FF, D_MODEL), D_FF ** -0.5),
    }


def reference(x, mix_norm, w_in, q_norm, k_norm, sinks, sgu_norm, w_s, b_s,
              w_oa, w_ob, w_out, ffn_norm, w_up, conv_w, conv_b, w_down):
    splits = (ATT_WIDTH,
              ATT_WIDTH + KV_WIDTH,
              ATT_WIDTH + 2 * KV_WIDTH,
              ATT_WIDTH + 2 * KV_WIDTH + SGU_WIDTH,
              ATT_WIDTH + 2 * KV_WIDTH + 2 * SGU_WIDTH,
              ATT_WIDTH + 2 * KV_WIDTH + 2 * SGU_WIDTH + D_MODEL)
    for l in range(DEPTH):
        h = rmsnorm(x, mix_norm[l])
        proj = h @ w_in[l]
        q, k, v, su, sv, g_a, g_b = jnp.split(proj, splits, axis=-1)
        y_att = sliding_window_attention(q, k, v, q_norm[l], k_norm[l], sinks[l])
        y_sgu = chunked_spatial_gating(su, sv, sgu_norm[l], w_s[l], b_s[l])
        merged = (jax.nn.sigmoid(g_a) * (y_att @ w_oa[l])
                  + jax.nn.sigmoid(g_b) * (y_sgu @ w_ob[l]))
        x = x + merged @ w_out[l]
        x = x + conv_gated_mlp(rmsnorm(x, ffn_norm[l]), w_up[l], conv_w[l], conv_b[l], w_down[l])
    return x
```

```cpp
#include <hip/hip_runtime.h>
#include <hip/hip_cooperative_groups.h>
#include <cstdio>
#include <cstdint>
namespace cg = cooperative_groups;
namespace pg8 {
#define PG8_LAS __attribute__((address_space(3)))
typedef unsigned short bf16_t;
typedef short bf16x8 __attribute__((ext_vector_type(8)));
typedef float f32x4 __attribute__((ext_vector_type(4)));
typedef unsigned u32x4 __attribute__((ext_vector_type(4)));
constexpr int BM = 256, BK = 64, HALF = 128, HTB = HALF * BK * 2  , STAGE_BYTES = 8 * HTB, NXCD = 8, WGM = 8;

__host__ __device__ __forceinline__ int lds_byte(int r, int c) { const int st = (r >> 4) * 2 + (c >> 5), rr = r & 15, cc = c & 31, ob = rr * 64 + cc * 2; return st * 1024 + (ob ^ (((ob >> 9) & 1) << 5)); }
__host__ __device__ __forceinline__ void stage_rc(int b, int& R, int& C) { const int st = b / 1024, sb = b % 1024, swz = sb ^ (((sb >> 9) & 1) << 5); R = (st >> 1) * 16 + swz / 64; C = (st & 1) * 32 + (swz % 64) / 2; }
__host__ __device__ __forceinline__ int perm32(int rho) { const int n = rho >> 4, i = rho & 15; return 8 * (i >> 2) + 4 * n + (i & 3); }

struct Unit { int pm, pn; };
struct Gemm { const bf16_t* A; const bf16_t* Bt; int M, N, K; };

struct StaticOrder {
    int nM, nN, nwg, G, c;
    __host__ __device__ void init(int M, int N, int G_, int c_) { nM = M / BM; nN = N / BM; nwg = nM * nN; G = G_; c = c_; }
    __host__ __device__ bool next(int i, Unit& u) const {
        const long L = (long)i * G + c; if (L >= nwg) return false;
        int wgid = (int)L; { const int q = nwg / NXCD, r = nwg % NXCD, xcd = wgid % NXCD, off = wgid / NXCD; wgid = (xcd < r ? xcd * (q + 1) : r * (q + 1) + (xcd - r) * q) + off; }
        const int nig = WGM * nN, gid = wgid / nig, fm = gid * WGM, gsz = (nM - fm) < WGM ? (nM - fm) : WGM;
        u.pm = fm + ((wgid % nig) % gsz); u.pn = (wgid % nig) / gsz; return true;
    }
    __device__ __forceinline__ void a_ready(const Unit&) const {}
    __device__ __forceinline__ void done(const Unit&) const {}
};

struct Gemm1Order : StaticOrder {
    __host__ __device__ bool next(int i, Unit& u) const {
        const long L = (long)i * G + c; if (L >= nwg) return false;
        int wgid = (int)L; { const int q = nwg / NXCD, r = nwg % NXCD, xcd = wgid % NXCD; int off = wgid / NXCD;
            if (G == 256 && nwg == 1920 && ((off >> 5) == 1 || (off >> 5) == 5)) off ^= 16;
            wgid = (xcd < r ? xcd * (q + 1) : r * (q + 1) + (xcd - r) * q) + off; }
        const int nig = WGM * nN, gid = wgid / nig, fm = gid * WGM, gsz = (nM - fm) < WGM ? (nM - fm) : WGM;
        u.pm = fm + ((wgid % nig) % gsz); u.pn = (wgid % nig) / gsz; return true;
    }
};

__device__ __forceinline__ unsigned cvt_pk_bf16(float lo, float hi) { unsigned r; asm volatile("v_cvt_pk_bf16_f32 %0, %1, %2" : "=v"(r) : "v"(lo), "v"(hi)); return r; }
__device__ __forceinline__ float bflo(unsigned u) { return __uint_as_float(u << 16); }
__device__ __forceinline__ float bfhi(unsigned u) { return __uint_as_float(u & 0xffff0000u); }
__device__ __forceinline__ float fexp2(float x) { return __builtin_amdgcn_exp2f(x); }
__device__ __forceinline__ float frcp(float x) { return __builtin_amdgcn_rcpf(x); }
__device__ __forceinline__ float gelu_tanh(float x) { const float in = x * (1.0f + 0.044715f * x * x); return x * frcp(1.0f + fexp2(-2.302208198f * in)); }

__device__ __forceinline__ float row_rs(const float* PS, int row, int fq) { return rsqrtf(PS[row] * (1.0f / 1024.0f) + 1e-6f); }
struct EpiProj {
    static constexpr bool PERM = true, AFTER_DRAIN = false, MID = false;
    bf16_t* O; int ldc; const float* PS;
    __device__ __forceinline__ static unsigned q8(float s) { return (unsigned)fminf(s * 256.0f, 255.0f); }
    __device__ __forceinline__ void operator()(const f32x4 (&acc)[2][2][4][2], const Unit& u, int wr, int wc, int fr, int fq) const {
        const int row0 = u.pm * BM + wr * 64 + fr, col0 = u.pn * BM + wc * 32 + 8 * fq;
        const bool act = (u.pn >= 3 && u.pn <= 6), sig = (u.pn >= 7);
#pragma unroll
        for (int ai = 0; ai < 2; ++ai)
#pragma unroll
            for (int m = 0; m < 4; ++m) { const int row = row0 + ai * HALF + m * 16; const float rs = row_rs(PS, row, fq);
                if (sig) {
                    unsigned w[4];
#pragma unroll
                    for (int bj = 0; bj < 2; ++bj) { const f32x4 v0 = acc[ai][bj][m][0] * rs, v1 = acc[ai][bj][m][1] * rs; unsigned b[8];
#pragma unroll
                        for (int j = 0; j < 4; ++j) { b[j] = q8(frcp(1.0f + fexp2(-1.4426950409f * v0[j]))); b[4 + j] = q8(frcp(1.0f + fexp2(-1.4426950409f * v1[j]))); }
                        w[2 * bj] = b[0] | (b[1] << 8) | (b[2] << 16) | (b[3] << 24); w[2 * bj + 1] = b[4] | (b[5] << 8) | (b[6] << 16) | (b[7] << 24); }
                    u32x4 wv; wv.x = w[0]; wv.y = w[1]; wv.z = w[2]; wv.w = w[3];
                    *(u32x4*)((unsigned char*)O + (size_t)row * (2 * ldc) + 3584 + 2 * ((u.pn - 7) * 128 + wc * 32 + 8 * fq)) = wv;
                } else {
                    bf16_t* rowp = O + (size_t)row * ldc + col0;
#pragma unroll
                    for (int bj = 0; bj < 2; ++bj) { f32x4 v0 = acc[ai][bj][m][0] * rs, v1 = acc[ai][bj][m][1] * rs;
                        if (act) {
#pragma unroll
                            for (int j = 0; j < 4; ++j) { v0[j] = gelu_tanh(v0[j]); v1[j] = gelu_tanh(v1[j]); } }
                        u32x4 w; w.x = cvt_pk_bf16(v0[0], v0[1]); w.y = cvt_pk_bf16(v0[2], v0[3]); w.z = cvt_pk_bf16(v1[0], v1[1]); w.w = cvt_pk_bf16(v1[2], v1[3]);
                        *(u32x4*)(rowp + bj * HALF) = w; } } }
    }
};
struct EpiMerge {
    static constexpr bool PERM = true, AFTER_DRAIN = false, MID = true;
    const bf16_t* P; bf16_t* O;
    __device__ __forceinline__ static float dq(unsigned w, int k) { return (float)((w >> (8 * k)) & 0xffu) + 0.5f; }
    __device__ __forceinline__ void mid(f32x4 (&acc)[2][2][4][2], const Unit& u, int wr, int wc, int fr, int fq) const {
        int row0 = u.pm * BM + wr * 64 + fr, col0 = u.pn * BM + wc * 32 + 8 * fq;
        asm volatile("" : "+v"(row0), "+v"(col0));
        u32x4 g[2][4][2];
#pragma unroll
        for (int ai = 0; ai < 2; ++ai)
#pragma unroll
            for (int m = 0; m < 4; ++m)
#pragma unroll
                for (int bj = 0; bj < 2; ++bj) g[ai][m][bj] = *(const u32x4*)((const unsigned char*)P + (size_t)(row0 + ai * HALF + m * 16) * 5888 + 3584 + 2 * (col0 + bj * HALF));
#pragma unroll
        for (int ai = 0; ai < 2; ++ai)
#pragma unroll
            for (int m = 0; m < 4; ++m)
#pragma unroll
                for (int bj = 0; bj < 2; ++bj)
#pragma unroll
                    for (int k = 0; k < 8; ++k) { const unsigned a = (k < 4) ? g[ai][m][bj].x : g[ai][m][bj].y, b = (k < 4) ? g[ai][m][bj].z : g[ai][m][bj].w;
                        acc[ai][bj][m][k >> 2][k & 3] *= dq(a, k & 3) * frcp(dq(b, k & 3)); }
    }
    __device__ __forceinline__ void operator()(const f32x4 (&acc)[2][2][4][2], const Unit& u, int wr, int wc, int fr, int fq) const {
        const int row0 = u.pm * BM + wr * 64 + fr, col0 = u.pn * BM + wc * 32 + 8 * fq;
        typedef unsigned u32x2 __attribute__((ext_vector_type(2)));
        u32x2 gb[2][4][2];
#pragma unroll
        for (int ai = 0; ai < 2; ++ai)
#pragma unroll
            for (int m = 0; m < 4; ++m)
#pragma unroll
                for (int bj = 0; bj < 2; ++bj) gb[ai][m][bj] = *(const u32x2*)((const unsigned char*)P + (size_t)(row0 + ai * HALF + m * 16) * 5888 + 3584 + 2 * (col0 + bj * HALF) + 8);
#pragma unroll
        for (int ai = 0; ai < 2; ++ai)
#pragma unroll
            for (int m = 0; m < 4; ++m) { const size_t r = (size_t)(row0 + ai * HALF + m * 16);
#pragma unroll
                for (int bj = 0; bj < 2; ++bj) {
                    float o[8];
#pragma unroll
                    for (int k = 0; k < 8; ++k) o[k] = acc[ai][bj][m][k >> 2][k & 3] * (dq((k < 4) ? gb[ai][m][bj].x : gb[ai][m][bj].y, k & 3) * (1.0f / 256.0f));
                    u32x4 w; w.x = cvt_pk_bf16(o[0], o[1]); w.y = cvt_pk_bf16(o[2], o[3]); w.z = cvt_pk_bf16(o[4], o[5]); w.w = cvt_pk_bf16(o[6], o[7]);
                    *(u32x4*)(O + r * 1024 + col0 + bj * HALF) = w; } }
    }
};
struct EpiResid {
    static constexpr bool PERM = true, AFTER_DRAIN = false, MID = false;
    const float* basef; const bf16_t* baseb; float* outf; bf16_t* outb; float* PS; int ldc;
    __device__ __forceinline__ void operator()(const f32x4 (&acc)[2][2][4][2], const Unit& u, int wr, int wc, int fr, int fq) const {
        const int row0 = u.pm * BM + wr * 64 + fr, col0 = u.pn * BM + wc * 32 + 8 * fq;
#pragma unroll
        for (int ai = 0; ai < 2; ++ai) {
            f32x4 bs[4][2][2];
            if (basef) {
#pragma unroll
                for (int m = 0; m < 4; ++m) { const size_t off = (size_t)(row0 + ai * HALF + m * 16) * ldc + col0;
#pragma unroll
                    for (int bj = 0; bj < 2; ++bj) { bs[m][bj][0] = *(const f32x4*)(basef + off + bj * HALF); bs[m][bj][1] = *(const f32x4*)(basef + off + bj * HALF + 4); } }
            } else {
                u32x4 rb[4][2];
#pragma unroll
                for (int m = 0; m < 4; ++m) { const size_t off = (size_t)(row0 + ai * HALF + m * 16) * ldc + col0;
#pragma unroll
                    for (int bj = 0; bj < 2; ++bj) rb[m][bj] = *(const u32x4*)(baseb + off + bj * HALF); }
#pragma unroll
                for (int m = 0; m < 4; ++m)
#pragma unroll
                    for (int bj = 0; bj < 2; ++bj) { bs[m][bj][0] = (f32x4){bflo(rb[m][bj].x), bfhi(rb[m][bj].x), bflo(rb[m][bj].y), bfhi(rb[m][bj].y)}; bs[m][bj][1] = (f32x4){bflo(rb[m][bj].z), bfhi(rb[m][bj].z), bflo(rb[m][bj].w), bfhi(rb[m][bj].w)}; }
            }
#pragma unroll
            for (int m = 0; m < 4; ++m) { const size_t off = (size_t)(row0 + ai * HALF + m * 16) * ldc + col0; float ss = 0.f;
#pragma unroll
                for (int bj = 0; bj < 2; ++bj) { const f32x4 o0 = bs[m][bj][0] + acc[ai][bj][m][0], o1 = bs[m][bj][1] + acc[ai][bj][m][1];
                    if (outf) { *(f32x4*)(outf + off + bj * HALF) = o0; *(f32x4*)(outf + off + bj * HALF + 4) = o1; }
                    else { ss += ((o0[0] * o0[0] + o0[1] * o0[1]) + (o0[2] * o0[2] + o0[3] * o0[3])) + ((o1[0] * o1[0] + o1[1] * o1[1]) + (o1[2] * o1[2] + o1[3] * o1[3]));
                        u32x4 w; w.x = cvt_pk_bf16(o0[0], o0[1]); w.y = cvt_pk_bf16(o0[2], o0[3]); w.z = cvt_pk_bf16(o1[0], o1[1]); w.w = cvt_pk_bf16(o1[2], o1[3]); *(u32x4*)(outb + off + bj * HALF) = w; } }
                if (!outf) { ss += __shfl_xor(ss, 16); ss += __shfl_xor(ss, 32); if (fq == 0) unsafeAtomicAdd(PS + (row0 + ai * HALF + m * 16), ss); } }
            asm volatile("" ::: "memory"); }
    }
};
__device__ __forceinline__ float dpp_shr1(float old, float src) { return __int_as_float(__builtin_amdgcn_update_dpp(__float_as_int(old), __float_as_int(src), 0x111, 0xf, 0xf, false)); }
__device__ __forceinline__ float dpp_shr2(float old, float src) { return __int_as_float(__builtin_amdgcn_update_dpp(__float_as_int(old), __float_as_int(src), 0x112, 0xf, 0xf, false)); }
__device__ __forceinline__ float dpp_ror1(float src) { return __int_as_float(__builtin_amdgcn_mov_dpp(__float_as_int(src), 0x121, 0xf, 0xf, true)); }
__device__ __forceinline__ float dpp_ror2(float src) { return __int_as_float(__builtin_amdgcn_mov_dpp(__float_as_int(src), 0x122, 0xf, 0xf, true)); }
struct EpiConv {
    static constexpr bool PERM = true, AFTER_DRAIN = false, MID = false;
    const bf16_t* cwb; bf16_t* act; bf16_t* halo; const float* PS;
    __device__ __forceinline__ void operator()(f32x4 (&acc)[2][2][4][2], const Unit& u, int wr, int wc, int fr, int fq) const {
        const int f0 = u.pn * 128 + wc * 32 + 8 * fq;
        const int row0 = u.pm * BM + wr * 64 + fr;
        u32x4 cq[2][4];
#pragma unroll
        for (int h = 0; h < 2; ++h)
#pragma unroll
            for (int k = 0; k < 4; ++k) cq[h][k] = *(const u32x4*)(cwb + k * 5632 + h * 2816 + f0);
#pragma unroll
        for (int ai = 0; ai < 2; ++ai)
#pragma unroll
            for (int m = 0; m < 4; ++m) { const float rs = row_rs(PS, row0 + ai * HALF + m * 16, fq);
#pragma unroll
                for (int bj = 0; bj < 2; ++bj) { acc[ai][bj][m][0] *= rs; acc[ai][bj][m][1] *= rs; } }
        if (fr < 2 || fr >= 14) {
#pragma unroll
            for (int ai = 0; ai < 2; ++ai)
#pragma unroll
                for (int bj = 0; bj < 2; ++bj) { const f32x4 a0 = (fr < 2) ? acc[ai][bj][0][0] : acc[ai][bj][3][0], a1 = (fr < 2) ? acc[ai][bj][0][1] : acc[ai][bj][3][1];
                    u32x4 w; w.x = cvt_pk_bf16(a0[0], a0[1]); w.y = cvt_pk_bf16(a0[2], a0[3]); w.z = cvt_pk_bf16(a1[0], a1[1]); w.w = cvt_pk_bf16(a1[2], a1[3]);
                    *(u32x4*)(halo + ((size_t)((u.pm * 4 + ai * 2 + wr) * 4) + (fr < 2 ? fr : fr - 12)) * 5632 + bj * 2816 + f0) = w; } }
#pragma unroll
        for (int ai = 0; ai < 2; ++ai) {
            unsigned pk[4][2][2];
#pragma unroll
            for (int n = 0; n < 2; ++n) {
#define CQ4(h, k) ((f32x4){bflo(n ? cq[h][k].z : cq[h][k].x), bfhi(n ? cq[h][k].z : cq[h][k].x), bflo(n ? cq[h][k].w : cq[h][k].y), bfhi(n ? cq[h][k].w : cq[h][k].y)})
                const f32x4 wg0 = CQ4(0, 0), wg1 = CQ4(0, 1), wg2 = CQ4(0, 2), bg = CQ4(0, 3);
                const f32x4 wv0 = CQ4(1, 0), wv1 = CQ4(1, 1), wv2 = CQ4(1, 2), bv = CQ4(1, 3);
#undef CQ4
                f32x4 pg1 = {0.f, 0.f, 0.f, 0.f}, pg2 = pg1, pv1 = pg1, pv2 = pg1;
#pragma unroll
                for (int m = 0; m < 4; ++m) {
                    const f32x4 zg = acc[ai][0][m][n], zv = acc[ai][1][m][n];
                    f32x4 g1, g2, v1, v2;
#pragma unroll
                    for (int j = 0; j < 4; ++j) { g1[j] = dpp_shr1(pg1[j], zg[j]); g2[j] = dpp_shr2(pg2[j], zg[j]); v1[j] = dpp_shr1(pv1[j], zv[j]); v2[j] = dpp_shr2(pv2[j], zv[j]);
                        pg1[j] = dpp_ror1(zg[j]); pg2[j] = dpp_ror2(zg[j]); pv1[j] = dpp_ror1(zv[j]); pv2[j] = dpp_ror2(zv[j]); }
                    const f32x4 cg_ = bg + wg0 * g2 + wg1 * g1 + wg2 * zg, cv_ = bv + wv0 * v2 + wv1 * v1 + wv2 * zv;
                    float o[4];
#pragma unroll
                    for (int j = 0; j < 4; ++j) o[j] = cg_[j] * frcp(1.0f + fexp2(-1.4426950409f * cg_[j])) * cv_[j];
                    pk[m][n][0] = cvt_pk_bf16(o[0], o[1]); pk[m][n][1] = cvt_pk_bf16(o[2], o[3]);
                }
            }
#pragma unroll
            for (int m = 0; m < 4; ++m) { u32x4 w; w.x = pk[m][0][0]; w.y = pk[m][0][1]; w.z = pk[m][1][0]; w.w = pk[m][1][1];
                *(u32x4*)(act + (size_t)(row0 + ai * HALF + m * 16) * 2816 + f0) = w; }
            asm volatile("" ::: "memory");
        }
    }
};

template <class Epi, class Sched, bool ALIGN_EPI = false, bool SP2 = false>
__device__ __forceinline__ void gemm_phase(PG8_LAS unsigned char* lds, const Gemm g, const Sched& S, const Epi& E, const int tid) {
    const int wid = __builtin_amdgcn_readfirstlane(tid >> 6), lane = tid & 63, wr = wid >> 2, wc = wid & 3, fr = lane & 15, fq = lane >> 4;
    const int K = g.K, nt = K / BK;
    unsigned voffA[2], voffB[2];
#pragma unroll
    for (int i = 0; i < 2; ++i) { int R, C; stage_rc(tid * 16 + i * 8192, R, C); const int Rb = Epi::PERM ? ((R & ~31) + perm32(R & 31)) : R;
        voffA[i] = (unsigned)(R * K + C) * 2u; voffB[i] = (unsigned)(Rb * K + C) * 2u; }
    const size_t kstep = (size_t)(BK * 2);
    const size_t hstep = (size_t)HALF * K * 2;
    const size_t tstep = 2 * hstep;
    const unsigned ldsw = (unsigned)wid * 1024u;
    const int aoff = lds_byte(wr * 64 + fr, fq * 8), boff = lds_byte(wc * 32 + fr, fq * 8);
#define PG8_SA(b, h) (((b) * 2 + (h)) * HTB)
#define PG8_SB(b, h) ((4 + (b) * 2 + (h)) * HTB)
#define PG8_STAGE(bufoff, gbase, voff) do { _Pragma("unroll") for (int _i = 0; _i < 2; ++_i) \
        __builtin_amdgcn_global_load_lds((const unsigned*)((const char*)(gbase) + (voff)[_i]), (PG8_LAS unsigned*)(lds + (bufoff) + ldsw + _i * 8192), 16, 0, 0); } while (0)
#define PG8_LDA(dst, b, h) do { _Pragma("unroll") for (int m = 0; m < 4; ++m) _Pragma("unroll") for (int k = 0; k < 2; ++k) dst[m][k] = *(const PG8_LAS bf16x8*)(lds + PG8_SA(b, h) + aoff + m * 2048 + k * 1024); } while (0)
#define PG8_LDB(dst, b, h) do { _Pragma("unroll") for (int n = 0; n < 2; ++n) _Pragma("unroll") for (int k = 0; k < 2; ++k) dst[n][k] = *(const PG8_LAS bf16x8*)(lds + PG8_SB(b, h) + boff + n * 2048 + k * 1024); } while (0)
#define PG8_MMA(ai, bj, At, Bt) do { __builtin_amdgcn_s_setprio(1); _Pragma("unroll") for (int m = 0; m < 4; ++m) _Pragma("unroll") for (int n = 0; n < 2; ++n) _Pragma("unroll") for (int k = 0; k < 2; ++k) \
        acc[ai][bj][m][n] = __builtin_amdgcn_mfma_f32_16x16x32_bf16(Bt[n][k], At[m][k], acc[ai][bj][m][n], 0, 0, 0); __builtin_amdgcn_s_setprio(0); } while (0)
#define PG8_WAIT_V(n) asm volatile("s_waitcnt vmcnt(" #n ")" ::: "memory")
#define PG8_WAIT_L(n) asm volatile("s_waitcnt lgkmcnt(" #n ")" ::: "memory")
#define PG8_BAR __builtin_amdgcn_s_barrier()
#define PG8_SCHED __builtin_amdgcn_sched_barrier(0)
    Unit cur, nxt; int ui = 0;
    if (!S.next(0, cur)) return;
    f32x4 acc[2][2][4][2];
#pragma unroll
    for (int a = 0; a < 2; ++a)
#pragma unroll
        for (int b = 0; b < 2; ++b)
#pragma unroll
            for (int m = 0; m < 4; ++m)
#pragma unroll
                for (int n = 0; n < 2; ++n) acc[a][b][m][n] = (f32x4){0.f, 0.f, 0.f, 0.f};
    bf16x8 At[4][2], B0[2][2], B1[2][2];
    const char* cA = (const char*)g.A + (size_t)cur.pm * tstep; const char* cB = (const char*)g.Bt + (size_t)cur.pn * tstep;
    S.a_ready(cur);
    if constexpr (SP2) {
        PG8_STAGE(PG8_SB(0, 0), cB, voffB); PG8_STAGE(PG8_SB(0, 1), cB + hstep, voffB); PG8_STAGE(PG8_SA(0, 0), cA, voffA); PG8_STAGE(PG8_SA(0, 1), cA + hstep, voffA);
        if (wr == 1) PG8_BAR;
        PG8_WAIT_V(2); PG8_BAR;
        PG8_STAGE(PG8_SB(1, 0), cB + kstep, voffB); PG8_STAGE(PG8_SA(1, 0), cA + kstep, voffA); PG8_STAGE(PG8_SB(1, 1), cB + hstep + kstep, voffB);
        PG8_WAIT_V(6); PG8_BAR;
    } else {
        PG8_STAGE(PG8_SB(0, 0), cB, voffB); PG8_STAGE(PG8_SA(0, 0), cA, voffA); PG8_STAGE(PG8_SB(0, 1), cB + hstep, voffB); PG8_STAGE(PG8_SA(0, 1), cA + hstep, voffA);
        if (wr == 1) PG8_BAR;
        PG8_WAIT_V(4); PG8_BAR;
        PG8_STAGE(PG8_SB(1, 0), cB + kstep, voffB); PG8_STAGE(PG8_SA(1, 0), cA + kstep, voffA); PG8_STAGE(PG8_SB(1, 1), cB + hstep + kstep, voffB);
        PG8_WAIT_V(6); PG8_BAR;
    }
    for (;;) {
        const bool has_next = S.next(ui + 1, nxt);
        const char* nA = has_next ? (const char*)g.A + (size_t)nxt.pm * tstep : cA; const char* nB = has_next ? (const char*)g.Bt + (size_t)nxt.pn * tstep : cB;
        for (int t = 0; t < nt; t += 2) {
            const bool last = (t == nt - 2);
            const char* a1 = cA + (size_t)(t + 1) * kstep;
            const char* a2 = last ? nA : cA + (size_t)(t + 2) * kstep; const char* b2 = last ? nB : cB + (size_t)(t + 2) * kstep;
            const char* a3 = a2 + kstep; const char* b3 = b2 + kstep;
            if (last && has_next) S.a_ready(nxt);
            if constexpr (Epi::MID) { if (t == nt / 2) { PG8_SCHED; E.mid(acc, cur, wr, wc, fr, fq); PG8_SCHED; } }
            if constexpr (SP2) {
            PG8_LDB(B0, 0, 0); PG8_LDB(B1, 0, 1); PG8_SCHED; PG8_LDA(At, 0, 0); PG8_STAGE(PG8_SA(1, 1), a1 + hstep, voffA);
            PG8_WAIT_V(8); PG8_WAIT_L(0); PG8_BAR; PG8_MMA(0, 0, At, B0); PG8_MMA(0, 1, At, B1); PG8_BAR; PG8_SCHED;
            PG8_LDA(At, 0, 1); PG8_STAGE(PG8_SB(0, 0), b2, voffB); PG8_STAGE(PG8_SB(0, 1), b2 + hstep, voffB); PG8_STAGE(PG8_SA(0, 0), a2, voffA);
            PG8_WAIT_V(8); PG8_WAIT_L(0); PG8_BAR; PG8_MMA(1, 0, At, B0); PG8_MMA(1, 1, At, B1); PG8_BAR; PG8_SCHED;
            PG8_LDB(B0, 1, 0); PG8_LDB(B1, 1, 1); PG8_SCHED; PG8_LDA(At, 1, 0); PG8_STAGE(PG8_SA(0, 1), a2 + hstep, voffA);
            PG8_WAIT_V(8); PG8_WAIT_L(0); PG8_BAR; PG8_MMA(0, 0, At, B0); PG8_MMA(0, 1, At, B1); PG8_BAR; PG8_SCHED;
            PG8_LDA(At, 1, 1); PG8_STAGE(PG8_SB(1, 0), b3, voffB); PG8_STAGE(PG8_SB(1, 1), b3 + hstep, voffB); PG8_STAGE(PG8_SA(1, 0), a3, voffA);
            PG8_WAIT_V(8); PG8_WAIT_L(0); PG8_BAR; PG8_MMA(1, 0, At, B0); PG8_MMA(1, 1, At, B1); PG8_BAR; PG8_SCHED;
            } else {
            PG8_LDB(B0, 0, 0); PG8_SCHED; PG8_LDA(At, 0, 0); PG8_STAGE(PG8_SA(1, 1), a1 + hstep, voffA);
            PG8_WAIT_L(8); PG8_BAR; PG8_WAIT_L(0); PG8_MMA(0, 0, At, B0); PG8_BAR; PG8_SCHED;
            PG8_LDB(B1, 0, 1); PG8_STAGE(PG8_SB(0, 0), b2, voffB);
            PG8_BAR; PG8_WAIT_L(0); PG8_MMA(0, 1, At, B1); PG8_BAR;
            PG8_LDA(At, 0, 1); PG8_STAGE(PG8_SA(0, 0), a2, voffA);
            PG8_BAR; PG8_WAIT_L(0); PG8_MMA(1, 0, At, B0); PG8_BAR; PG8_SCHED;
            PG8_STAGE(PG8_SB(0, 1), b2 + hstep, voffB);
            PG8_WAIT_V(6); PG8_BAR; PG8_MMA(1, 1, At, B1); PG8_BAR;
            PG8_LDB(B0, 1, 0); PG8_SCHED; PG8_LDA(At, 1, 0); PG8_STAGE(PG8_SA(0, 1), a2 + hstep, voffA);
            PG8_WAIT_L(8); PG8_BAR; PG8_WAIT_L(0); PG8_MMA(0, 0, At, B0); PG8_BAR; PG8_SCHED;
            PG8_LDB(B1, 1, 1); PG8_STAGE(PG8_SB(1, 0), b3, voffB);
            PG8_BAR; PG8_WAIT_L(0); PG8_MMA(0, 1, At, B1); PG8_BAR;
            PG8_LDA(At, 1, 1); PG8_STAGE(PG8_SA(1, 0), a3, voffA);
            PG8_BAR; PG8_WAIT_L(0); PG8_MMA(1, 0, At, B0); PG8_BAR; PG8_SCHED;
            PG8_STAGE(PG8_SB(1, 1), b3 + hstep, voffB);
            PG8_WAIT_V(6); PG8_BAR; PG8_MMA(1, 1, At, B1); PG8_BAR;
            }
        }
        if constexpr (ALIGN_EPI) { if (wr == 0) PG8_BAR; }
        if constexpr (!Epi::AFTER_DRAIN) { E(acc, cur, wr, wc, fr, fq); S.done(cur); }
        if (!has_next) break;
#pragma unroll
        for (int a = 0; a < 2; ++a)
#pragma unroll
            for (int b = 0; b < 2; ++b)
#pragma unroll
                for (int m = 0; m < 4; ++m)
#pragma unroll
                    for (int n = 0; n < 2; ++n) acc[a][b][m][n] = (f32x4){0.f, 0.f, 0.f, 0.f};
        cur = nxt; cA = nA; cB = nB; ++ui;
        if constexpr (ALIGN_EPI) { if (wr == 1) PG8_BAR; }
    }
    PG8_WAIT_V(0);
    if constexpr (!ALIGN_EPI) { if (wr == 0) PG8_BAR; }
    PG8_BAR;
    if constexpr (Epi::AFTER_DRAIN) { E.fused(acc, cur, wr, wc, fr, fq, lds, wid, lane); S.done(cur); }
#undef PG8_SA
#undef PG8_SB
#undef PG8_STAGE
#undef PG8_LDA
#undef PG8_LDB
#undef PG8_MMA
#undef PG8_WAIT_V
#undef PG8_WAIT_L
#undef PG8_BAR
#undef PG8_SCHED
}
}

#define LAS __attribute__((address_space(3)))
typedef unsigned short bf16;
typedef unsigned v4u __attribute__((ext_vector_type(4)));
typedef unsigned v2u __attribute__((ext_vector_type(2)));
typedef float f32x4 __attribute__((ext_vector_type(4)));
typedef short bf16x8 __attribute__((ext_vector_type(8)));
using pg8::cvt_pk_bf16; using pg8::bflo; using pg8::bfhi; using pg8::fexp2; using pg8::frcp;

constexpr int NWAVES = 8;
constexpr int SEQ = 2048, M = 32768, D = 1024, INW = 3840, DFF = 2816, NUP = 5632;
constexpr int PP = 2944;
constexpr int C_K = 512, C_V = 640, C_SU = 768, C_SV = 1280;
constexpr float EPS = 1e-6f, LOG2E = 1.4426950408889634f;
constexpr size_t MiB = (size_t)1 << 20;
constexpr size_t O_WIN = 0, O_WAB = O_WIN + (size_t)INW * D * 2, O_WOUT = O_WAB + 2 * MiB, O_WUP = O_WOUT + 2 * MiB, O_WDN = O_WUP + (size_t)NUP * D * 2, O_WSG = O_WDN + (size_t)D * DFF * 2, LSTRIDE = O_WSG + MiB / 4 + MiB / 4;
constexpr size_t WS_H = 2 * LSTRIDE, WS_Y = WS_H + 64 * MiB, WS_P = WS_Y + 64 * MiB, WS_HALO = WS_P + 240 * MiB, WS_CTL = WS_HALO + (size_t)512 * 4 * NUP * 4, WS_PS = WS_CTL + 16384, CTL_ZERO_BYTES = 16384 + 4 * (size_t)M * 4, WS_CWB = WS_CTL + CTL_ZERO_BYTES, WS_END = WS_CWB + (size_t)2 * 4 * NUP * 2;
constexpr int LDS_BYTES = 144 * 1024;
static_assert(LSTRIDE % 256 == 0 && WS_END <= 512 * MiB, "workspace map");

__device__ __forceinline__ float wave_sum(float v) {
#pragma unroll
    for (int o = 1; o < 64; o <<= 1) v += __shfl_xor(v, o);
    return v;
}
template <int UPMAP  >
__device__ __forceinline__ void cvt_item(const float* W, int N, bf16* WT, int ldk, int koff, LAS float* scr, int item, int lane, const float* gain = nullptr) {
    const int nblk = N / 32, kb = item / nblk, nb = item % nblk, k0 = 64 * kb, n0 = 32 * nb;
    float wv[32];
#pragma unroll
    for (int i = 0; i < 32; ++i) { const int kk = 2 * i + (lane >> 5); wv[i] = __builtin_nontemporal_load(W + (size_t)(k0 + kk) * N + n0 + (lane & 31)); }
    if (gain) {
#pragma unroll
        for (int i = 0; i < 32; ++i) wv[i] *= gain[k0 + 2 * i + (lane >> 5)]; }
#pragma unroll
    for (int i = 0; i < 32; ++i) { const int kk = 2 * i + (lane >> 5); scr[kk * 33 + (lane & 31)] = wv[i]; }
    asm volatile("s_waitcnt lgkmcnt(0)" ::: "memory");
    const int c = lane & 7;
#pragma unroll
    for (int j = 0; j < 4; ++j) { const int n = (lane >> 3) + 8 * j; const LAS float* s = scr + (8 * c) * 33 + n;
        v4u o; o.x = cvt_pk_bf16(s[0 * 33], s[1 * 33]); o.y = cvt_pk_bf16(s[2 * 33], s[3 * 33]); o.z = cvt_pk_bf16(s[4 * 33], s[5 * 33]); o.w = cvt_pk_bf16(s[6 * 33], s[7 * 33]);
        int row = n0 + n;
        if (UPMAP == 1) { const int f = row < DFF ? row : row - DFF; row = (f >> 7) * 256 + (row < DFF ? 0 : 128) + (f & 127); }
        if (UPMAP == 2) { if (row >= 1792) { const int gi = row - 1792, c = gi & 1023; row = 1792 + (c >> 7) * 256 + (gi < 1024 ? 0 : 128) + (c & 127); } }
        *(v4u*)(WT + (size_t)row * ldk + koff + k0 + 8 * c) = o; }
    asm volatile("s_waitcnt lgkmcnt(0)" ::: "memory");
}
template <class A> __device__ __forceinline__ void p0_convert(const A& a, LAS unsigned char* lds, int gw, int NGW, int wave, int lane) {
    LAS float* scr = (LAS float*)(lds + wave * 8448);
    constexpr int I_IN = (D / 64) * (INW / 32), I_OA = (512 / 64) * (D / 32), I_OUT = (D / 64) * (D / 32), I_UP = (D / 64) * (NUP / 32), I_DN = (DFF / 64) * (D / 32);
    constexpr int PER_L = I_IN + 2 * I_OA + I_OUT + I_UP + I_DN;
    for (int it = gw; it < 2 * PER_L; it += NGW) {
        const int l = it / PER_L; int r = it % PER_L; unsigned char* wl = a.ws + (size_t)l * LSTRIDE;
        if (r < I_IN) { cvt_item<2>(a.in[2] + (size_t)l * D * INW, INW, (bf16*)(wl + O_WIN), D, 0, scr, r, lane, a.in[1] + l * D); continue; } r -= I_IN;
        if (r < I_OA) { cvt_item<0>(a.in[9] + (size_t)l * 512 * D, D, (bf16*)(wl + O_WAB), D, 0, scr, r, lane); continue; } r -= I_OA;
        if (r < I_OA) { cvt_item<0>(a.in[10] + (size_t)l * 512 * D, D, (bf16*)(wl + O_WAB), D, 512, scr, r, lane); continue; } r -= I_OA;
        if (r < I_OUT) { cvt_item<0>(a.in[11] + (size_t)l * D * D, D, (bf16*)(wl + O_WOUT), D, 0, scr, r, lane); continue; } r -= I_OUT;
        if (r < I_UP) { cvt_item<1>(a.in[13] + (size_t)l * D * NUP, NUP, (bf16*)(wl + O_WUP), D, 0, scr, r, lane, a.in[12] + l * D); continue; } r -= I_UP;
        cvt_item<0>(a.in[16] + (size_t)l * DFF * D, D, (bf16*)(wl + O_WDN), DFF, 0, scr, r, lane);
    }
    for (int e = gw * 64 + lane; e < 2 * 4 * NUP; e += NGW * 64) { const int l = e / (4 * NUP), k = (e / NUP) & 3, c = e % NUP;
        const float w = (k < 3) ? a.in[14][(size_t)l * 3 * NUP + (size_t)k * NUP + c] : a.in[15][(size_t)l * NUP + c]; ((bf16*)(a.ws + WS_CWB))[e] = (bf16)(cvt_pk_bf16(w, 0.f) & 0xffffu); }
    for (int e = gw * 64 + lane; e < 2 * 8 * 128 * 128; e += NGW * 64) { const int l = e >> 17, r = e & 131071, i = (r >> 7) & 127, j = r & 127;
        const float w = a.in[7][e]; ((bf16*)(a.ws + (size_t)l * LSTRIDE + O_WSG))[r] = (bf16)(cvt_pk_bf16(j <= i ? w : 0.f, 0.f) & 0xffffu); }
}
__device__ __forceinline__ void xb_phase(const float* x, bf16* h, float* PS, int gw, int NGW, int lane) {
    for (int row = gw; row < M; row += NGW) {
        const f32x4* xr = (const f32x4*)(x + (size_t)row * D) + lane; f32x4 v[4]; float s = 0.f;
#pragma unroll
        for (int j = 0; j < 4; ++j) { v[j] = __builtin_nontemporal_load(xr + 64 * j); s += (v[j].x * v[j].x + v[j].y * v[j].y) + (v[j].z * v[j].z + v[j].w * v[j].w); }
        s = wave_sum(s);
        v2u* o = (v2u*)(h + (size_t)row * D) + lane;
#pragma unroll
        for (int j = 0; j < 4; ++j) { v2u w; w.x = cvt_pk_bf16(v[j].x, v[j].y); w.y = cvt_pk_bf16(v[j].z, v[j].w); o[64 * j] = w; }
        if (lane == 0) PS[row] = s;
    }
    for (int e = gw * 64 + lane; e < 3 * M; e += NGW * 64) PS[M + e] = 0.f;
}
__device__ __forceinline__ void attn_item(LAS unsigned char* lds, const bf16* P, bf16* Y, const float* qg, const float* kg, const float* sinks, int item, int tid) {
    const int hkv = item & 1, nb = (item >> 1) & 15, b = item >> 5;
    const int R0 = b * SEQ + nb * 128;
    LAS bf16* Ks = (LAS bf16*)lds; LAS bf16* Vt = (LAS bf16*)(lds + 36864);
    v4u qraw[4][2];
    { const int w_ = tid >> 6, ln = tid & 63; const bf16* qp = P + (size_t)(R0 + (w_ & 1) * 64 + (ln & 15)) * PP + (hkv * 4 + (w_ >> 1)) * 64 + 8 * (ln >> 4);
#pragma unroll
      for (int it = 0; it < 4; ++it) { qraw[it][0] = *(const v4u*)(qp + (size_t)(16 * it) * PP); qraw[it][1] = *(const v4u*)(qp + (size_t)(16 * it) * PP + 32); } }
#pragma unroll
    for (int i = 0; i < 4; ++i) {
        const int task = tid + 512 * i, key = task >> 3, c = task & 7; const bool ok = (nb > 0) || (key >= 128);
        v4u kr = {0u, 0u, 0u, 0u}, vr = {0u, 0u, 0u, 0u};
        if (ok) { const bf16* rp = P + (size_t)(R0 - 128 + key) * PP + hkv * 64 + 8 * c; kr = *(const v4u*)(rp + C_K); vr = *(const v4u*)(rp + C_V); }
        float kf[8];
#pragma unroll
        for (int e = 0; e < 4; ++e) { kf[2 * e] = bflo(kr[e]); kf[2 * e + 1] = bfhi(kr[e]); }
        float ss = 0.f;
#pragma unroll
        for (int e = 0; e < 8; ++e) ss += kf[e] * kf[e];
        ss += __shfl_xor(ss, 1); ss += __shfl_xor(ss, 2); ss += __shfl_xor(ss, 4);
        const float rs = rsqrtf(ss * (1.f / 64.f) + EPS);
        const f32x4 g0 = *(const f32x4*)(kg + 8 * c), g1 = *(const f32x4*)(kg + 8 * c + 4);
        v4u kw; kw.x = cvt_pk_bf16(kf[0] * rs * g0.x, kf[1] * rs * g0.y); kw.y = cvt_pk_bf16(kf[2] * rs * g0.z, kf[3] * rs * g0.w);
        kw.z = cvt_pk_bf16(kf[4] * rs * g1.x, kf[5] * rs * g1.y); kw.w = cvt_pk_bf16(kf[6] * rs * g1.z, kf[7] * rs * g1.w);
        *(LAS v4u*)(Ks + key * 72 + 8 * c) = kw;
#pragma unroll
        for (int e = 0; e < 4; ++e) { Vt[(8 * c + 2 * e) * 264 + key] = (bf16)(vr[e] & 0xffffu); Vt[(8 * c + 2 * e + 1) * 264 + key] = (bf16)(vr[e] >> 16); }
    }
    __syncthreads();
    const int w = tid >> 6, lane = tid & 63, fr = lane & 15, fq = lane >> 4, g = w >> 1, h = hkv * 4 + g, half = w & 1;
    const float slope2 = exp2f(-(float)(h + 1)) * LOG2E, sink2 = sinks[h] * LOG2E;
    f32x4 qgv[4];
#pragma unroll
    for (int ks = 0; ks < 2; ++ks) { qgv[2 * ks] = *(const f32x4*)(qg + 32 * ks + 8 * fq); qgv[2 * ks + 1] = *(const f32x4*)(qg + 32 * ks + 8 * fq + 4); }
    const int d0i = fr + 128 - 4 * fq; const float t0 = -slope2 * (float)d0i;
    float be[2][4];
#pragma unroll
    for (int r = 0; r < 4; ++r) { const int da = d0i - r, db8 = d0i - 128 - r; be[0][r] = (da < 128) ? -slope2 * (float)da : -1e30f; be[1][r] = (db8 >= 0) ? -slope2 * (float)db8 : -1e30f; }
#pragma unroll 1
    for (int it = 0; it < 4; ++it) {
        const int qb = half * 4 + it, i0 = 16 * qb;
        const v4u q0 = qraw[0][0], q1 = qraw[0][1];
#pragma unroll
        for (int k = 0; k < 3; ++k) { qraw[k][0] = qraw[k + 1][0]; qraw[k][1] = qraw[k + 1][1]; }
        float qf[16];
#pragma unroll
        for (int e = 0; e < 4; ++e) { qf[2 * e] = bflo(q0[e]); qf[2 * e + 1] = bfhi(q0[e]); qf[8 + 2 * e] = bflo(q1[e]); qf[8 + 2 * e + 1] = bfhi(q1[e]); }
        float ss = 0.f;
#pragma unroll
        for (int e = 0; e < 16; ++e) ss += qf[e] * qf[e];
        ss += __shfl_xor(ss, 16); ss += __shfl_xor(ss, 32);
        const float rs = rsqrtf(ss * (1.f / 64.f) + EPS) * (0.125f * LOG2E);
        bf16x8 qa[2];
#pragma unroll
        for (int ks = 0; ks < 2; ++ks) { v4u t;
            t.x = cvt_pk_bf16(qf[8 * ks + 0] * rs * qgv[2 * ks].x, qf[8 * ks + 1] * rs * qgv[2 * ks].y); t.y = cvt_pk_bf16(qf[8 * ks + 2] * rs * qgv[2 * ks].z, qf[8 * ks + 3] * rs * qgv[2 * ks].w);
            t.z = cvt_pk_bf16(qf[8 * ks + 4] * rs * qgv[2 * ks + 1].x, qf[8 * ks + 5] * rs * qgv[2 * ks + 1].y); t.w = cvt_pk_bf16(qf[8 * ks + 6] * rs * qgv[2 * ks + 1].z, qf[8 * ks + 7] * rs * qgv[2 * ks + 1].w);
            qa[ks] = __builtin_bit_cast(bf16x8, t); }
        f32x4 sc[9];
#pragma unroll
        for (int k9 = 0; k9 < 9; ++k9) { f32x4 accs = {0.f, 0.f, 0.f, 0.f};
#pragma unroll
            for (int ks = 0; ks < 2; ++ks) { const bf16x8 kfr = *(const LAS bf16x8*)(Ks + (16 * (qb + k9) + fr) * 72 + 32 * ks + 8 * fq); accs = __builtin_amdgcn_mfma_f32_16x16x32_bf16(kfr, qa[ks], accs, 0, 0, 0); }
            sc[k9] = accs; }
        float mx = sink2;
#pragma unroll
        for (int k9 = 0; k9 < 9; ++k9) { const bool nokey = (nb == 0) && (qb + k9 < 8);
#pragma unroll
            for (int r = 0; r < 4; ++r) {
                float s = (k9 == 0) ? sc[k9][r] + be[0][r] : (k9 == 8) ? sc[k9][r] + be[1][r] : sc[k9][r] + __builtin_fmaf(slope2, (float)(16 * k9 + r), t0);
                s = nokey ? -1e30f : s; sc[k9][r] = s; mx = fmaxf(mx, s); } }
        mx = fmaxf(mx, __shfl_xor(mx, 16)); mx = fmaxf(mx, __shfl_xor(mx, 32));
        float l = 0.f;
#pragma unroll
        for (int k9 = 0; k9 < 9; ++k9)
#pragma unroll
            for (int r = 0; r < 4; ++r) { const float p = fexp2(sc[k9][r] - mx); sc[k9][r] = p; l += p; }
        l += __shfl_xor(l, 16); l += __shfl_xor(l, 32);
        const float inv = 1.0f / (l + fexp2(sink2 - mx));
        f32x4 o[4];
#pragma unroll
        for (int db = 0; db < 4; ++db) o[db] = (f32x4){0.f, 0.f, 0.f, 0.f};
#pragma unroll
        for (int gp = 0; gp < 5; ++gp) {
            v4u t; t.x = cvt_pk_bf16(sc[2 * gp][0] * inv, sc[2 * gp][1] * inv); t.y = cvt_pk_bf16(sc[2 * gp][2] * inv, sc[2 * gp][3] * inv);
            if (gp < 4) { t.z = cvt_pk_bf16(sc[2 * gp + 1][0] * inv, sc[2 * gp + 1][1] * inv); t.w = cvt_pk_bf16(sc[2 * gp + 1][2] * inv, sc[2 * gp + 1][3] * inv); } else { t.z = 0u; t.w = 0u; }
            const bf16x8 pf = __builtin_bit_cast(bf16x8, t);
            const int kb0 = qb + 2 * gp, kb1 = (gp < 4) ? kb0 + 1 : kb0;
#pragma unroll
            for (int db = 0; db < 4; ++db) { const LAS bf16* vp = Vt + (16 * db + fr) * 264 + 4 * fq;
                const v2u va = *(const LAS v2u*)(vp + 16 * kb0), vb = *(const LAS v2u*)(vp + 16 * kb1);
                v4u vv; vv.x = va.x; vv.y = va.y; vv.z = vb.x; vv.w = vb.y;
                o[db] = __builtin_amdgcn_mfma_f32_16x16x32_bf16(__builtin_bit_cast(bf16x8, vv), pf, o[db], 0, 0, 0); }
        }
        bf16* yp = Y + (size_t)(R0 + i0 + fr) * D + h * 64 + 4 * fq;
#pragma unroll
        for (int db = 0; db < 4; ++db) { v2u wv; wv.x = cvt_pk_bf16(o[db][0], o[db][1]); wv.y = cvt_pk_bf16(o[db][2], o[db][3]); *(v2u*)(yp + 16 * db) = wv; }
    }
    __syncthreads();
}
__device__ __forceinline__ void sgu_item(LAS unsigned char* lds, const bf16* P, bf16* Y, const float* gain, const bf16* Wsb, const float* bs, int item, int tid) {
    const int R0 = item * 128;
    const int g = __builtin_amdgcn_readfirstlane(tid >> 6), lane = tid & 63, fr = lane & 15, fq = lane >> 4;
    LAS float* part = (LAS float*)lds;
    LAS bf16* Vt = (LAS bf16*)(lds + 4096) + g * (64 * 136);
    v4u r[2][8];
#pragma unroll
    for (int p = 0; p < 2; ++p) { const bf16* rp = P + (size_t)(R0 + 2 * lane + p) * PP + C_SV + g * 64;
#pragma unroll
        for (int c = 0; c < 8; ++c) r[p][c] = *(const v4u*)(rp + 8 * c); }
    const bf16* Wg = Wsb + g * 16384;
#pragma unroll
    for (int p = 0; p < 2; ++p) { float ss = 0.f;
#pragma unroll
        for (int c = 0; c < 8; ++c)
#pragma unroll
            for (int e = 0; e < 4; ++e) { const float a0 = bflo(r[p][c][e]), a1 = bfhi(r[p][c][e]); ss += a0 * a0 + a1 * a1; }
        part[g * 128 + 2 * lane + p] = ss; }
    __syncthreads();
    float rs[2];
#pragma unroll
    for (int p = 0; p < 2; ++p) { float t = 0.f;
#pragma unroll
        for (int q = 0; q < 8; ++q) t += part[q * 128 + 2 * lane + p];
        rs[p] = rsqrtf(t * (1.f / 512.f) + EPS); }
#pragma unroll
    for (int c = 0; c < 8; ++c)
#pragma unroll
        for (int e = 0; e < 4; ++e) {
            const unsigned w0 = cvt_pk_bf16(bflo(r[0][c][e]) * rs[0], bflo(r[1][c][e]) * rs[1]), w1 = cvt_pk_bf16(bfhi(r[0][c][e]) * rs[0], bfhi(r[1][c][e]) * rs[1]);
            *(LAS unsigned*)(Vt + (8 * c + 2 * e) * 136 + 2 * lane) = w0; *(LAS unsigned*)(Vt + (8 * c + 2 * e + 1) * 136 + 2 * lane) = w1; }
    f32x4 gn[4];
#pragma unroll
    for (int db = 0; db < 4; ++db) gn[db] = *(const f32x4*)(gain + g * 64 + 16 * db + 4 * fq);
    __syncthreads();
    bf16x8 wfr[8][4]; v2u sur[8][4]; float bia[8];
#pragma unroll
    for (int ib = 0; ib < 8; ++ib) { const bf16* wp = Wg + (16 * ib + fr) * 128 + 8 * fq;
#pragma unroll
        for (int ks = 0; ks < 4; ++ks) if (ks <= (ib >> 1)) wfr[ib][ks] = *(const bf16x8*)(wp + 32 * ks);
        const bf16* up = P + (size_t)(R0 + 16 * ib + fr) * PP + C_SU + g * 64 + 4 * fq;
#pragma unroll
        for (int db = 0; db < 4; ++db) sur[ib][db] = *(const v2u*)(up + 16 * db);
        bia[ib] = bs[g * 128 + 16 * ib + fr]; }
#pragma unroll
    for (int ib = 0; ib < 8; ++ib) {
        f32x4 acc[4];
#pragma unroll
        for (int db = 0; db < 4; ++db) acc[db] = (f32x4){0.f, 0.f, 0.f, 0.f};
#pragma unroll
        for (int ks = 0; ks < 4; ++ks) if (ks <= (ib >> 1)) {
#pragma unroll
            for (int db = 0; db < 4; ++db) { const bf16x8 vf = *(const LAS bf16x8*)(Vt + (16 * db + fr) * 136 + 32 * ks + 8 * fq); acc[db] = __builtin_amdgcn_mfma_f32_16x16x32_bf16(vf, wfr[ib][ks], acc[db], 0, 0, 0); } }
        bf16* yp = Y + (size_t)(R0 + 16 * ib + fr) * D + 512 + g * 64 + 4 * fq; const float bias = bia[ib];
#pragma unroll
        for (int db = 0; db < 4; ++db) {
            v2u wv; wv.x = cvt_pk_bf16(bflo(sur[ib][db].x) * (acc[db][0] * gn[db][0] + bias), bfhi(sur[ib][db].x) * (acc[db][1] * gn[db][1] + bias));
            wv.y = cvt_pk_bf16(bflo(sur[ib][db].y) * (acc[db][2] * gn[db][2] + bias), bfhi(sur[ib][db].y) * (acc[db][3] * gn[db][3] + bias));
            *(v2u*)(yp + 16 * db) = wv; }
    }
    __syncthreads();
}
__device__ __forceinline__ void fixup_phase(const bf16* halo, const float* cw, const float* cb, bf16* act, int gtid, int nthreads) {
    for (int e = gtid; e < 512 * (DFF / 4); e += nthreads) {
        const int s = e / (DFF / 4), f = (e % (DFF / 4)) * 4; const bool first = (s & 31) == 0;
        const bf16* hs = halo + (size_t)s * 4 * NUP; const bf16* hpv = hs - (size_t)4 * NUP;
        float r0[4], r1[4];
#pragma unroll
        for (int half = 0; half < 2; ++half) { const int col = f + half * DFF; const v2u a0 = *(const v2u*)(hs + col), a1 = *(const v2u*)(hs + NUP + col);
            v2u am2 = {0u, 0u}, am1 = am2; if (!first) { am2 = *(const v2u*)(hpv + 2 * NUP + col); am1 = *(const v2u*)(hpv + 3 * NUP + col); }
            const f32x4 z0 = {bflo(a0.x), bfhi(a0.x), bflo(a0.y), bfhi(a0.y)}, z1 = {bflo(a1.x), bfhi(a1.x), bflo(a1.y), bfhi(a1.y)};
            const f32x4 zm2 = {bflo(am2.x), bfhi(am2.x), bflo(am2.y), bfhi(am2.y)}, zm1 = {bflo(am1.x), bfhi(am1.x), bflo(am1.y), bfhi(am1.y)};
            const f32x4 w0 = *(const f32x4*)(cw + col), w1 = *(const f32x4*)(cw + NUP + col), w2 = *(const f32x4*)(cw + 2 * NUP + col), bb = *(const f32x4*)(cb + col);
            const f32x4 c0 = bb + w0 * zm2 + w1 * zm1 + w2 * z0, c1 = bb + w0 * zm1 + w1 * z0 + w2 * z1;
#pragma unroll
            for (int j = 0; j < 4; ++j) { if (half == 0) { r0[j] = c0[j] * frcp(1.0f + fexp2(-LOG2E * c0[j])); r1[j] = c1[j] * frcp(1.0f + fexp2(-LOG2E * c1[j])); } else { r0[j] *= c0[j]; r1[j] *= c1[j]; } } }
        v2u o0, o1; o0.x = cvt_pk_bf16(r0[0], r0[1]); o0.y = cvt_pk_bf16(r0[2], r0[3]); o1.x = cvt_pk_bf16(r1[0], r1[1]); o1.y = cvt_pk_bf16(r1[2], r1[3]);
        *(v2u*)(act + (size_t)(64 * s) * DFF + f) = o0; *(v2u*)(act + (size_t)(64 * s + 1) * DFF + f) = o1;
    }
}

#ifndef PHM
#define PHM 511
#endif
#define XB_TMO      128
#define XB_XCNT(j)  (256  + 64 * (j))
#define XB_XSUB(j)  (1280 + 64 * (j))
#define XB_XGEN(j)  (2304 + 64 * (j))
#define XB_TOP      3328
#define XB_TOPGEN   3392
#define XCD_BAR_WORDS 3456
#define XB_SPIN_CAP (1u << 18)
__device__ __forceinline__ unsigned xb_ld(unsigned* p)              { return __hip_atomic_load(p, __ATOMIC_RELAXED, __HIP_MEMORY_SCOPE_AGENT); }
__device__ __forceinline__ unsigned xb_add(unsigned* p, unsigned v) { return __hip_atomic_fetch_add(p, v, __ATOMIC_RELAXED, __HIP_MEMORY_SCOPE_AGENT); }
__device__ __forceinline__ unsigned xb_xcc_id() { return (unsigned)__builtin_amdgcn_s_getreg((3 << 11) | 20) & 0xFu; }
#define XB_SPIN(cond, bar) do { unsigned _sp = 0; while (cond) { __builtin_amdgcn_s_sleep(1); \
    if ((++_sp & 255u) == 0u) { if (xb_ld(&(bar)[XB_TMO])) break; if (_sp > XB_SPIN_CAP) { atomicAdd(&(bar)[XB_TMO], 1u); break; } } } } while (0)
struct XcdBarrier { unsigned* bar; unsigned x; volatile LAS unsigned* st; };
__device__ __forceinline__ XcdBarrier xcd_barrier_post(unsigned* bar, volatile LAS unsigned* st) {
    XcdBarrier b; b.bar = bar; b.x = xb_xcc_id(); b.st = st;
    if (threadIdx.x == 0) (void)xb_add(&bar[XB_XCNT(b.x)], 1u);
    return b;
}
__device__ __forceinline__ void xcd_barrier_complete(unsigned* bar, unsigned x, unsigned& nloc, unsigned& nx) {
    const unsigned G = gridDim.x * gridDim.y * gridDim.z;
    unsigned sum, cnt, mine, sp = 0u;
    for (;;) {
        sum = 0u; cnt = 0u; mine = 0u;
#pragma unroll
        for (unsigned j = 0; j < 16; ++j) { const unsigned c = xb_ld(&bar[XB_XCNT(j)]); sum += c; cnt += (c > 0u) ? 1u : 0u; mine = (j == x) ? c : mine; }
        if (sum == G) break;
        __builtin_amdgcn_s_sleep(1);
        if ((++sp & 255u) == 0u) { if (xb_ld(&bar[XB_TMO])) break; if (sp > XB_SPIN_CAP) { atomicAdd(&bar[XB_TMO], 1u); break; } }
    }
    nloc = mine > 0u ? mine : 1u; nx = cnt > 0u ? cnt : 1u;
}
__device__ __forceinline__ void xcd_barrier(const XcdBarrier& b) {
    asm volatile("s_waitcnt vmcnt(0)" ::: "memory");
    __syncthreads();
    if (threadIdx.x == 0) {
        unsigned* bar = b.bar;
        __builtin_amdgcn_s_waitcnt(0);
        unsigned nloc = b.st[0], nx = b.st[1];
        if (nloc == 0u) { xcd_barrier_complete(bar, b.x, nloc, nx); b.st[0] = nloc; b.st[1] = nx; }
        const unsigned old = xb_add(&bar[XB_XSUB(b.x)], 1u);
        const unsigned gen = old / nloc;
        if (old + 1u == (gen + 1u) * nloc) {
            __builtin_amdgcn_fence(__ATOMIC_RELEASE, "agent");
            asm volatile("s_waitcnt vmcnt(0)" ::: "memory");
            const unsigned og = xb_add(&bar[XB_TOP], 1u);
            const unsigned tg = og / nx;
            if (og + 1u == (tg + 1u) * nx) xb_add(&bar[XB_TOPGEN], 1u);
            else XB_SPIN(xb_ld(&bar[XB_TOPGEN]) == tg, bar);
            __builtin_amdgcn_fence(__ATOMIC_ACQUIRE, "agent");
            xb_add(&bar[XB_XGEN(b.x)], 1u);
            asm volatile("s_waitcnt vmcnt(0)" ::: "memory");
        } else {
            XB_SPIN(xb_ld(&bar[XB_XGEN(b.x)]) == gen, bar);
            __builtin_amdgcn_fence(__ATOMIC_ACQUIRE, "agent");
            asm volatile("s_waitcnt vmcnt(0)" ::: "memory");
        }
    }
    __syncthreads();
}
#ifndef PROBE_DOUBLE
#define PROBE_DOUBLE 0
#endif
#ifndef PROBE_SYNCS
#define PROBE_SYNCS 0
#endif
struct Args { const float* in[17]; float* out; unsigned char* ws; int ph_lo, ph_hi; };
constexpr int N_PHASES = 15;
__global__ void __launch_bounds__(NWAVES * 64, 2) fwd_kernel(Args args) {
    extern __shared__ __attribute__((aligned(16))) unsigned char lds_raw[];
    LAS unsigned char* lds = (LAS unsigned char*)lds_raw;
    cg::grid_group grid = cg::this_grid();
    if (threadIdx.x < 4) ((LAS unsigned*)(lds + LDS_BYTES - 16))[threadIdx.x] = 0u;
    __syncthreads();
    XcdBarrier xb = xcd_barrier_post((unsigned*)(args.ws + WS_CTL), (volatile LAS unsigned*)(lds + LDS_BYTES - 16));
    const Args& a = args;
    bf16* const Hb = (bf16*)(a.ws + WS_H); bf16* const Yb = (bf16*)(a.ws + WS_Y); bf16* const Pb = (bf16*)(a.ws + WS_P); bf16* const halo = (bf16*)(a.ws + WS_HALO); bf16* const Xb = (bf16*)a.out;     float* const PS = (float*)(a.ws + WS_PS);
#pragma unroll 1
    for (int ph = args.ph_lo; ph < args.ph_hi; ++ph) {
      const int nrep = ((PROBE_DOUBLE >> (ph == 0 ? 9 : (ph - 1) % 7)) & 1) ? 2 : 1;
#pragma unroll 1
      for (int rep = 0; rep < nrep; ++rep) {
        int tid = threadIdx.x; asm volatile("" : "+v"(tid));
        int bid = blockIdx.x; asm volatile("" : "+s"(bid));
        const int lane = tid & 63, wave = __builtin_amdgcn_readfirstlane(tid >> 6);
        const int G = gridDim.x, gw = bid * NWAVES + wave, NGW = G * NWAVES;
        if (ph == 0) { if (PHM & 1) { p0_convert(a, lds, gw, NGW, wave, lane); xb_phase(a.in[0], Hb, PS, gw, NGW, lane); } }
        else {
            const int l = (ph - 1) / 7, sp = (ph - 1) % 7; unsigned char* wl = a.ws + (size_t)l * LSTRIDE;
            const bf16* Ain = (l == 0) ? Hb : Xb;
            if (sp == 0 && (PHM & 4)) { pg8::Gemm g{Ain, (const bf16*)(wl + O_WIN), M, INW, D}; pg8::Gemm1Order S; S.init(M, INW, G, bid); pg8::EpiProj E{Pb, PP, PS + (size_t)(2 * l) * M};
                pg8::gemm_phase<pg8::EpiProj, pg8::Gemm1Order, true, true>(lds, g, S, E, tid); }
            else if (sp == 1 && (PHM & 8)) {
                for (int it = bid; it < 768; it += G) {
                    if (it < 512) attn_item(lds, Pb, Yb, a.in[3] + l * 64, a.in[4] + l * 64, a.in[5] + l * 8, it, tid);
                    else sgu_item(lds, Pb, Yb, a.in[6] + l * 512, (const bf16*)(wl + O_WSG), a.in[8] + l * 1024, it - 512, tid);
                } }
            else if (sp == 2 && (PHM & 16)) { pg8::Gemm g{Yb, (const bf16*)(wl + O_WAB), M, D, D}; pg8::StaticOrder S; S.init(M, D, G, bid); pg8::EpiMerge E{Pb, Hb};
                pg8::gemm_phase<pg8::EpiMerge, pg8::StaticOrder, true, true>(lds, g, S, E, tid); }
            else if (sp == 3 && (PHM & 32)) { pg8::Gemm g{Hb, (const bf16*)(wl + O_WOUT), M, D, D}; pg8::StaticOrder S; S.init(M, D, G, bid); pg8::EpiResid E{(l == 0) ? a.in[0] : (const float*)nullptr, Xb, (float*)nullptr, Yb, PS + (size_t)(2 * l + 1) * M, D};
                pg8::gemm_phase<pg8::EpiResid, pg8::StaticOrder, true, true>(lds, g, S, E, tid); }
            else if (sp == 4 && (PHM & 64)) { pg8::Gemm g{Yb, (const bf16*)(wl + O_WUP), M, NUP, D}; pg8::StaticOrder S; S.init(M, NUP, G, bid); pg8::EpiConv E{(const bf16*)(a.ws + WS_CWB) + (size_t)l * 4 * NUP, Pb, halo, PS + (size_t)(2 * l + 1) * M};
                pg8::gemm_phase<pg8::EpiConv, pg8::StaticOrder, true, true>(lds, g, S, E, tid); }
            else if (sp == 5) { if (PHM & 128) fixup_phase(halo, a.in[14] + (size_t)l * 3 * NUP, a.in[15] + (size_t)l * NUP, Pb, bid * 512 + tid, G * 512); }
            else if (sp == 6 && (PHM & 256)) { pg8::Gemm g{Pb, (const bf16*)(wl + O_WDN), M, D, DFF}; pg8::StaticOrder S; S.init(M, D, G, bid); pg8::EpiResid E{(const float*)nullptr, Yb, (l == 0) ? (float*)nullptr : a.out, Xb, PS + (size_t)2 * M, D};
                pg8::gemm_phase<pg8::EpiResid, pg8::StaticOrder, true, true>(lds, g, S, E, tid); }
        }
        if (ph + 1 < args.ph_hi || rep + 1 < nrep) { if (args.ph_hi > 1000) grid.sync(); else xcd_barrier(xb); } else __syncthreads();
        for (int e = 0; e < PROBE_SYNCS; ++e) xcd_barrier(xb);
      }
    }
}

#ifndef MK_PER_PHASE
#define MK_PER_PHASE 0
#endif
extern "C" void kernel_launch(void* const* d_in, const int* in_sizes, int n_in, void* d_out, int out_size, void* d_ws, size_t ws_size, hipStream_t stream) {
    static int grid = 0;
    if (grid == 0) {
        if (n_in != 17 || out_size != M * D || ws_size < WS_END) { fprintf(stderr, "kernel_launch: unexpected shapes (n_in %d out %d ws %zu, need %zu)\n", n_in, out_size, ws_size, (size_t)WS_END); grid = -1; return; }
        int dev = 0, cus = 0, per_cu = 0;
        hipGetDevice(&dev); hipDeviceGetAttribute(&cus, hipDeviceAttributeMultiprocessorCount, dev);
        if (hipFuncSetAttribute((const void*)fwd_kernel, hipFuncAttributeMaxDynamicSharedMemorySize, LDS_BYTES) != hipSuccess) { fprintf(stderr, "kernel_launch: hipFuncSetAttribute failed\n"); grid = -1; return; }
        if (hipOccupancyMaxActiveBlocksPerMultiprocessor(&per_cu, (const void*)fwd_kernel, NWAVES * 64, LDS_BYTES) != hipSuccess || per_cu < 1) { fprintf(stderr, "kernel_launch: occupancy query says %d\n", per_cu); per_cu = 1; }
        (void)hipGetLastError();
        grid = cus * 1;
        fprintf(stderr, "kernel_launch: grid %d (cus %d, per_cu %d)\n", grid, cus, per_cu);
    }
    if (grid < 0) return;
    if (hipMemsetAsync((char*)d_ws + WS_CTL, 0, 16384, stream) != hipSuccess) { fprintf(stderr, "kernel_launch: memset failed\n"); return; }
    Args a{};
    for (int i = 0; i < 17; ++i) a.in[i] = (const float*)d_in[i];
    a.out = (float*)d_out; a.ws = (unsigned char*)d_ws;
#if MK_PER_PHASE
    for (int ph = 0; ph < N_PHASES; ++ph) { a.ph_lo = ph; a.ph_hi = ph + 1; hipLaunchKernelGGL(fwd_kernel, dim3(grid), dim3(NWAVES * 64), LDS_BYTES, stream, a); }
#else
    a.ph_lo = 0; a.ph_hi = N_PHASES;
    void* kargs[] = {&a};
    hipError_t e = hipLaunchCooperativeKernel((const void*)fwd_kernel, dim3(grid), dim3(NWAVES * 64), kargs, LDS_BYTES, stream);
    if (e != hipSuccess) fprintf(stderr, "kernel_launch: cooperative launch failed: %s (grid %d)\n", hipGetErrorString(e), grid);
#endif
}
```

```cpp
#include <hip/hip_runtime.h>
#include <hip/hip_cooperative_groups.h>
#include <cstdio>
#include <cstdint>
namespace cg = cooperative_groups;
namespace pg8 {
#define PG8_LAS __attribute__((address_space(3)))
typedef unsigned short bf16_t;
typedef short bf16x8 __attribute__((ext_vector_type(8)));
typedef float f32x4 __attribute__((ext_vector_type(4)));
typedef unsigned u32x4 __attribute__((ext_vector_type(4)));
constexpr int BM = 256, BK = 64, HALF = 128, HTB = HALF * BK * 2  , STAGE_BYTES = 8 * HTB, NXCD = 8, WGM = 8;

__host__ __device__ __forceinline__ int lds_byte(int r, int c) { const int st = (r >> 4) * 2 + (c >> 5), rr = r & 15, cc = c & 31, ob = rr * 64 + cc * 2; return st * 1024 + (ob ^ (((ob >> 9) & 1) << 5)); }
__host__ __device__ __forceinline__ void stage_rc(int b, int& R, int& C) { const int st = b / 1024, sb = b % 1024, swz = sb ^ (((sb >> 9) & 1) << 5); R = (st >> 1) * 16 + swz / 64; C = (st & 1) * 32 + (swz % 64) / 2; }
__host__ __device__ __forceinline__ int perm32(int rho) { const int n = rho >> 4, i = rho & 15; return 8 * (i >> 2) + 4 * n + (i & 3); }

struct Unit { int pm, pn; };
struct Gemm { const bf16_t* A; const bf16_t* Bt; int M, N, K; };

struct StaticOrder {
    int nM, nN, nwg, G, c;
    __host__ __device__ void init(int M, int N, int G_, int c_) { nM = M / BM; nN = N / BM; nwg = nM * nN; G = G_; c = c_; }
    __host__ __device__ bool next(int i, Unit& u) const {
        const long L = (long)i * G + c; if (L >= nwg) return false;
        int wgid = (int)L; { const int q = nwg / NXCD, r = nwg % NXCD, xcd = wgid % NXCD, off = wgid / NXCD; wgid = (xcd < r ? xcd * (q + 1) : r * (q + 1) + (xcd - r) * q) + off; }
        const int nig = WGM * nN, gid = wgid / nig, fm = gid * WGM, gsz = (nM - fm) < WGM ? (nM - fm) : WGM;
        u.pm = fm + ((wgid % nig) % gsz); u.pn = (wgid % nig) / gsz; return true;
    }
    __device__ __forceinline__ void a_ready(const Unit&) const {}
    __device__ __forceinline__ void done(const Unit&) const {}
};

struct Gemm1Order : StaticOrder {
    __host__ __device__ bool next(int i, Unit& u) const {
        const long L = (long)i * G + c; if (L >= nwg) return false;
        int wgid = (int)L; { const int q = nwg / NXCD, r = nwg % NXCD, xcd = wgid % NXCD; int off = wgid / NXCD;
            if (G == 256 && nwg == 1920 && ((off >> 5) == 1 || (off >> 5) == 5)) off ^= 16;
            wgid = (xcd < r ? xcd * (q + 1) : r * (q + 1) + (xcd - r) * q) + off; }
        const int nig = WGM * nN, gid = wgid / nig, fm = gid * WGM, gsz = (nM - fm) < WGM ? (nM - fm) : WGM;
        u.pm = fm + ((wgid % nig) % gsz); u.pn = (wgid % nig) / gsz; return true;
    }
};

__device__ __forceinline__ unsigned cvt_pk_bf16(float lo, float hi) { unsigned r; asm volatile("v_cvt_pk_bf16_f32 %0, %1, %2" : "=v"(r) : "v"(lo), "v"(hi)); return r; }
__device__ __forceinline__ float bflo(unsigned u) { return __uint_as_float(u << 16); }
__device__ __forceinline__ float bfhi(unsigned u) { return __uint_as_float(u & 0xffff0000u); }
__device__ __forceinline__ float fexp2(float x) { return __builtin_amdgcn_exp2f(x); }
__device__ __forceinline__ float frcp(float x) { return __builtin_amdgcn_rcpf(x); }
__device__ __forceinline__ float gelu_tanh(float x) { const float in = x * (1.0f + 0.044715f * x * x); return x * frcp(1.0f + fexp2(-2.302208198f * in)); }

__device__ __forceinline__ float row_rs(const float* PS, int row, int fq) { return rsqrtf(PS[row] * (1.0f / 1024.0f) + 1e-6f); }
struct EpiProj {
    static constexpr bool PERM = true, AFTER_DRAIN = false, MID = false;
    bf16_t* O; int ldc; const float* PS;
    __device__ __forceinline__ static unsigned q8(float s) { return (unsigned)fminf(s * 256.0f, 255.0f); }
    __device__ __forceinline__ void operator()(const f32x4 (&acc)[2][2][4][2], const Unit& u, int wr, int wc, int fr, int fq) const {
        const int row0 = u.pm * BM + wr * 64 + fr, col0 = u.pn * BM + wc * 32 + 8 * fq;
        const bool act = (u.pn >= 3 && u.pn <= 6), sig = (u.pn >= 7);
#pragma unroll
        for (int ai = 0; ai < 2; ++ai)
#pragma unroll
            for (int m = 0; m < 4; ++m) { const int row = row0 + ai * HALF + m * 16; const float rs = row_rs(PS, row, fq);
                if (sig) {
                    unsigned w[4];
#pragma unroll
                    for (int bj = 0; bj < 2; ++bj) { const f32x4 v0 = acc[ai][bj][m][0] * rs, v1 = acc[ai][bj][m][1] * rs; unsigned b[8];
#pragma unroll
                        for (int j = 0; j < 4; ++j) { b[j] = q8(frcp(1.0f + fexp2(-1.4426950409f * v0[j]))); b[4 + j] = q8(frcp(1.0f + fexp2(-1.4426950409f * v1[j]))); }
                        w[2 * bj] = b[0] | (b[1] << 8) | (b[2] << 16) | (b[3] << 24); w[2 * bj + 1] = b[4] | (b[5] << 8) | (b[6] << 16) | (b[7] << 24); }
                    u32x4 wv; wv.x = w[0]; wv.y = w[1]; wv.z = w[2]; wv.w = w[3];
                    *(u32x4*)((unsigned char*)O + (size_t)row * (2 * ldc) + 3584 + 2 * ((u.pn - 7) * 128 + wc * 32 + 8 * fq)) = wv;
                } else {
                    bf16_t* rowp = O + (size_t)row * ldc + col0;
#pragma unroll
                    for (int bj = 0; bj < 2; ++bj) { f32x4 v0 = acc[ai][bj][m][0] * rs, v1 = acc[ai][bj][m][1] * rs;
                        if (act) {
#pragma unroll
                            for (int j = 0; j < 4; ++j) { v0[j] = gelu_tanh(v0[j]); v1[j] = gelu_tanh(v1[j]); } }
                        u32x4 w; w.x = cvt_pk_bf16(v0[0], v0[1]); w.y = cvt_pk_bf16(v0[2], v0[3]); w.z = cvt_pk_bf16(v1[0], v1[1]); w.w = cvt_pk_bf16(v1[2], v1[3]);
                        *(u32x4*)(rowp + bj * HALF) = w; } } }
    }
};
struct EpiMerge {
    static constexpr bool PERM = true, AFTER_DRAIN = false, MID = true;
    const bf16_t* P; bf16_t* O;
    __device__ __forceinline__ static float dq(unsigned w, int k) { return (float)((w >> (8 * k)) & 0xffu) + 0.5f; }
    __device__ __forceinline__ void mid(f32x4 (&acc)[2][2][4][2], const Unit& u, int wr, int wc, int fr, int fq) const {
        int row0 = u.pm * BM + wr * 64 + fr, col0 = u.pn * BM + wc * 32 + 8 * fq;
        asm volatile("" : "+v"(row0), "+v"(col0));
        u32x4 g[2][4][2];
#pragma unroll
        for (int ai = 0; ai < 2; ++ai)
#pragma unroll
            for (int m = 0; m < 4; ++m)
#pragma unroll
                for (int bj = 0; bj < 2; ++bj) g[ai][m][bj] = *(const u32x4*)((const unsigned char*)P + (size_t)(row0 + ai * HALF + m * 16) * 5888 + 3584 + 2 * (col0 + bj * HALF));
#pragma unroll
        for (int ai = 0; ai < 2; ++ai)
#pragma unroll
            for (int m = 0; m < 4; ++m)
#pragma unroll
                for (int bj = 0; bj < 2; ++bj)
#pragma unroll
                    for (int k = 0; k < 8; ++k) { const unsigned a = (k < 4) ? g[ai][m][bj].x : g[ai][m][bj].y, b = (k < 4) ? g[ai][m][bj].z : g[ai][m][bj].w;
                        acc[ai][bj][m][k >> 2][k & 3] *= dq(a, k & 3) * frcp(dq(b, k & 3)); }
    }
    __device__ __forceinline__ void operator()(const f32x4 (&acc)[2][2][4][2], const Unit& u, int wr, int wc, int fr, int fq) const {
        const int row0 = u.pm * BM + wr * 64 + fr, col0 = u.pn * BM + wc * 32 + 8 * fq;
        typedef unsigned u32x2 __attribute__((ext_vector_type(2)));
        u32x2 gb[2][4][2];
#pragma unroll
        for (int ai = 0; ai < 2; ++ai)
#pragma unroll
            for (int m = 0; m < 4; ++m)
#pragma unroll
                for (int bj = 0; bj < 2; ++bj) gb[ai][m][bj] = *(const u32x2*)((const unsigned char*)P + (size_t)(row0 + ai * HALF + m * 16) * 5888 + 3584 + 2 * (col0 + bj * HALF) + 8);
#pragma unroll
        for (int ai = 0; ai < 2; ++ai)
#pragma unroll
            for (int m = 0; m < 4; ++m) { const size_t r = (size_t)(row0 + ai * HALF + m * 16);
#pragma unroll
                for (int bj = 0; bj < 2; ++bj) {
                    float o[8];
#pragma unroll
                    for (int k = 0; k < 8; ++k) o[k] = acc[ai][bj][m][k >> 2][k & 3] * (dq((k < 4) ? gb[ai][m][bj].x : gb[ai][m][bj].y, k & 3) * (1.0f / 256.0f));
                    u32x4 w; w.x = cvt_pk_bf16(o[0], o[1]); w.y = cvt_pk_bf16(o[2], o[3]); w.z = cvt_pk_bf16(o[4], o[5]); w.w = cvt_pk_bf16(o[6], o[7]);
                    *(u32x4*)(O + r * 1024 + col0 + bj * HALF) = w; } }
    }
};
struct EpiResid {
    static constexpr bool PERM = true, AFTER_DRAIN = false, MID = false;
    const float* basef; const bf16_t* baseb; float* outf; bf16_t* outb; float* PS; int ldc;
    __device__ __forceinline__ void operator()(const f32x4 (&acc)[2][2][4][2], const Unit& u, int wr, int wc, int fr, int fq) const {
        const int row0 = u.pm * BM + wr * 64 + fr, col0 = u.pn * BM + wc * 32 + 8 * fq;
#pragma unroll
        for (int ai = 0; ai < 2; ++ai) {
            f32x4 bs[4][2][2];
            if (basef) {
#pragma unroll
                for (int m = 0; m < 4; ++m) { const size_t off = (size_t)(row0 + ai * HALF + m * 16) * ldc + col0;
#pragma unroll
                    for (int bj = 0; bj < 2; ++bj) { bs[m][bj][0] = *(const f32x4*)(basef + off + bj * HALF); bs[m][bj][1] = *(const f32x4*)(basef + off + bj * HALF + 4); } }
            } else {
                u32x4 rb[4][2];
#pragma unroll
                for (int m = 0; m < 4; ++m) { const size_t off = (size_t)(row0 + ai * HALF + m * 16) * ldc + col0;
#pragma unroll
                    for (int bj = 0; bj < 2; ++bj) rb[m][bj] = *(const u32x4*)(baseb + off + bj * HALF); }
#pragma unroll
                for (int m = 0; m < 4; ++m)
#pragma unroll
                    for (int bj = 0; bj < 2; ++bj) { bs[m][bj][0] = (f32x4){bflo(rb[m][bj].x), bfhi(rb[m][bj].x), bflo(rb[m][bj].y), bfhi(rb[m][bj].y)}; bs[m][bj][1] = (f32x4){bflo(rb[m][bj].z), bfhi(rb[m][bj].z), bflo(rb[m][bj].w), bfhi(rb[m][bj].w)}; }
            }
#pragma unroll
            for (int m = 0; m < 4; ++m) { const size_t off = (size_t)(row0 + ai * HALF + m * 16) * ldc + col0; float ss = 0.f;
#pragma unroll
                for (int bj = 0; bj < 2; ++bj) { const f32x4 o0 = bs[m][bj][0] + acc[ai][bj][m][0], o1 = bs[m][bj][1] + acc[ai][bj][m][1];
                    if (outf) { __builtin_nontemporal_store(o0, (f32x4*)(outf + off + bj * HALF)); __builtin_nontemporal_store(o1, (f32x4*)(outf + off + bj * HALF + 4)); }
                    else { ss += ((o0[0] * o0[0] + o0[1] * o0[1]) + (o0[2] * o0[2] + o0[3] * o0[3])) + ((o1[0] * o1[0] + o1[1] * o1[1]) + (o1[2] * o1[2] + o1[3] * o1[3]));
                        u32x4 w; w.x = cvt_pk_bf16(o0[0], o0[1]); w.y = cvt_pk_bf16(o0[2], o0[3]); w.z = cvt_pk_bf16(o1[0], o1[1]); w.w = cvt_pk_bf16(o1[2], o1[3]); *(u32x4*)(outb + off + bj * HALF) = w; } }
                if (!outf) { ss += __shfl_xor(ss, 16); ss += __shfl_xor(ss, 32); if (fq == 0) unsafeAtomicAdd(PS + (row0 + ai * HALF + m * 16), ss); } }
            asm volatile("" ::: "memory"); }
    }
};
__device__ __forceinline__ float dpp_shr1(float old, float src) { return __int_as_float(__builtin_amdgcn_update_dpp(__float_as_int(old), __float_as_int(src), 0x111, 0xf, 0xf, false)); }
__device__ __forceinline__ float dpp_shr2(float old, float src) { return __int_as_float(__builtin_amdgcn_update_dpp(__float_as_int(old), __float_as_int(src), 0x112, 0xf, 0xf, false)); }
__device__ __forceinline__ float dpp_ror1(float src) { return __int_as_float(__builtin_amdgcn_mov_dpp(__float_as_int(src), 0x121, 0xf, 0xf, true)); }
__device__ __forceinline__ float dpp_ror2(float src) { return __int_as_float(__builtin_amdgcn_mov_dpp(__float_as_int(src), 0x122, 0xf, 0xf, true)); }
struct EpiConv {
    static constexpr bool PERM = true, AFTER_DRAIN = false, MID = false;
    const bf16_t* cwb; bf16_t* act; bf16_t* halo; const float* PS;
    __device__ __forceinline__ void operator()(f32x4 (&acc)[2][2][4][2], const Unit& u, int wr, int wc, int fr, int fq) const {
        const int f0 = u.pn * 128 + wc * 32 + 8 * fq;
        const int row0 = u.pm * BM + wr * 64 + fr;
        u32x4 cq[2][4];
#pragma unroll
        for (int h = 0; h < 2; ++h)
#pragma unroll
            for (int k = 0; k < 4; ++k) cq[h][k] = *(const u32x4*)(cwb + k * 5632 + h * 2816 + f0);
#pragma unroll
        for (int ai = 0; ai < 2; ++ai)
#pragma unroll
            for (int m = 0; m < 4; ++m) { const float rs = row_rs(PS, row0 + ai * HALF + m * 16, fq);
#pragma unroll
                for (int bj = 0; bj < 2; ++bj) { acc[ai][bj][m][0] *= rs; acc[ai][bj][m][1] *= rs; } }
        if (fr < 2 || fr >= 14) {
#pragma unroll
            for (int ai = 0; ai < 2; ++ai)
#pragma unroll
                for (int bj = 0; bj < 2; ++bj) { const f32x4 a0 = (fr < 2) ? acc[ai][bj][0][0] : acc[ai][bj][3][0], a1 = (fr < 2) ? acc[ai][bj][0][1] : acc[ai][bj][3][1];
                    u32x4 w; w.x = cvt_pk_bf16(a0[0], a0[1]); w.y = cvt_pk_bf16(a0[2], a0[3]); w.z = cvt_pk_bf16(a1[0], a1[1]); w.w = cvt_pk_bf16(a1[2], a1[3]);
                    *(u32x4*)(halo + ((size_t)((u.pm * 4 + ai * 2 + wr) * 4) + (fr < 2 ? fr : fr - 12)) * 5632 + bj * 2816 + f0) = w; } }
#pragma unroll
        for (int ai = 0; ai < 2; ++ai) {
            unsigned pk[4][2][2];
#pragma unroll
            for (int n = 0; n < 2; ++n) {
#define CQ4(h, k) ((f32x4){bflo(n ? cq[h][k].z : cq[h][k].x), bfhi(n ? cq[h][k].z : cq[h][k].x), bflo(n ? cq[h][k].w : cq[h][k].y), bfhi(n ? cq[h][k].w : cq[h][k].y)})
                const f32x4 wg0 = CQ4(0, 0), wg1 = CQ4(0, 1), wg2 = CQ4(0, 2), bg = CQ4(0, 3);
                const f32x4 wv0 = CQ4(1, 0), wv1 = CQ4(1, 1), wv2 = CQ4(1, 2), bv = CQ4(1, 3);
#undef CQ4
                f32x4 pg1 = {0.f, 0.f, 0.f, 0.f}, pg2 = pg1, pv1 = pg1, pv2 = pg1;
#pragma unroll
                for (int m = 0; m < 4; ++m) {
                    const f32x4 zg = acc[ai][0][m][n], zv = acc[ai][1][m][n];
                    f32x4 g1, g2, v1, v2;
#pragma unroll
                    for (int j = 0; j < 4; ++j) { g1[j] = dpp_shr1(pg1[j], zg[j]); g2[j] = dpp_shr2(pg2[j], zg[j]); v1[j] = dpp_shr1(pv1[j], zv[j]); v2[j] = dpp_shr2(pv2[j], zv[j]);
                        pg1[j] = dpp_ror1(zg[j]); pg2[j] = dpp_ror2(zg[j]); pv1[j] = dpp_ror1(zv[j]); pv2[j] = dpp_ror2(zv[j]); }
                    const f32x4 cg_ = bg + wg0 * g2 + wg1 * g1 + wg2 * zg, cv_ = bv + wv0 * v2 + wv1 * v1 + wv2 * zv;
                    float o[4];
#pragma unroll
                    for (int j = 0; j < 4; ++j) o[j] = cg_[j] * frcp(1.0f + fexp2(-1.4426950409f * cg_[j])) * cv_[j];
                    pk[m][n][0] = cvt_pk_bf16(o[0], o[1]); pk[m][n][1] = cvt_pk_bf16(o[2], o[3]);
                }
            }
#pragma unroll
            for (int m = 0; m < 4; ++m) { u32x4 w; w.x = pk[m][0][0]; w.y = pk[m][0][1]; w.z = pk[m][1][0]; w.w = pk[m][1][1];
                *(u32x4*)(act + (size_t)(row0 + ai * HALF + m * 16) * 2816 + f0) = w; }
            asm volatile("" ::: "memory");
        }
    }
};

template <class Epi, class Sched, bool ALIGN_EPI = false, bool SP2 = false>
__device__ __forceinline__ void gemm_phase(PG8_LAS unsigned char* lds, const Gemm g, const Sched& S, const Epi& E, const int tid) {
    const int wid = __builtin_amdgcn_readfirstlane(tid >> 6), lane = tid & 63, wr = wid >> 2, wc = wid & 3, fr = lane & 15, fq = lane >> 4;
    const int K = g.K, nt = K / BK;
    unsigned voffA[2], voffB[2];
#pragma unroll
    for (int i = 0; i < 2; ++i) { int R, C; stage_rc(tid * 16 + i * 8192, R, C); const int Rb = Epi::PERM ? ((R & ~31) + perm32(R & 31)) : R;
        voffA[i] = (unsigned)(R * K + C) * 2u; voffB[i] = (unsigned)(Rb * K + C) * 2u; }
    const size_t kstep = (size_t)(BK * 2);
    const size_t hstep = (size_t)HALF * K * 2;
    const size_t tstep = 2 * hstep;
    const unsigned ldsw = (unsigned)wid * 1024u;
    const int aoff = lds_byte(wr * 64 + fr, fq * 8), boff = lds_byte(wc * 32 + fr, fq * 8);
#define PG8_SA(b, h) (((b) * 2 + (h)) * HTB)
#define PG8_SB(b, h) ((4 + (b) * 2 + (h)) * HTB)
#define PG8_STAGE(bufoff, gbase, voff) do { _Pragma("unroll") for (int _i = 0; _i < 2; ++_i) \
        __builtin_amdgcn_global_load_lds((const unsigned*)((const char*)(gbase) + (voff)[_i]), (PG8_LAS unsigned*)(lds + (bufoff) + ldsw + _i * 8192), 16, 0, 0); } while (0)
#define PG8_LDA(dst, b, h) do { _Pragma("unroll") for (int m = 0; m < 4; ++m) _Pragma("unroll") for (int k = 0; k < 2; ++k) dst[m][k] = *(const PG8_LAS bf16x8*)(lds + PG8_SA(b, h) + aoff + m * 2048 + k * 1024); } while (0)
#define PG8_LDB(dst, b, h) do { _Pragma("unroll") for (int n = 0; n < 2; ++n) _Pragma("unroll") for (int k = 0; k < 2; ++k) dst[n][k] = *(const PG8_LAS bf16x8*)(lds + PG8_SB(b, h) + boff + n * 2048 + k * 1024); } while (0)
#define PG8_MMA(ai, bj, At, Bt) do { __builtin_amdgcn_s_setprio(1); _Pragma("unroll") for (int m = 0; m < 4; ++m) _Pragma("unroll") for (int n = 0; n < 2; ++n) _Pragma("unroll") for (int k = 0; k < 2; ++k) \
        acc[ai][bj][m][n] = __builtin_amdgcn_mfma_f32_16x16x32_bf16(Bt[n][k], At[m][k], acc[ai][bj][m][n], 0, 0, 0); __builtin_amdgcn_s_setprio(0); } while (0)
#define PG8_WAIT_V(n) asm volatile("s_waitcnt vmcnt(" #n ")" ::: "memory")
#define PG8_WAIT_L(n) asm volatile("s_waitcnt lgkmcnt(" #n ")" ::: "memory")
#define PG8_BAR __builtin_amdgcn_s_barrier()
#define PG8_SCHED __builtin_amdgcn_sched_barrier(0)
    Unit cur, nxt; int ui = 0;
    if (!S.next(0, cur)) return;
    f32x4 acc[2][2][4][2];
#pragma unroll
    for (int a = 0; a < 2; ++a)
#pragma unroll
        for (int b = 0; b < 2; ++b)
#pragma unroll
            for (int m = 0; m < 4; ++m)
#pragma unroll
                for (int n = 0; n < 2; ++n) acc[a][b][m][n] = (f32x4){0.f, 0.f, 0.f, 0.f};
    bf16x8 At[4][2], B0[2][2], B1[2][2];
    const char* cA = (const char*)g.A + (size_t)cur.pm * tstep; const char* cB = (const char*)g.Bt + (size_t)cur.pn * tstep;
    S.a_ready(cur);
    if constexpr (SP2) {
        PG8_STAGE(PG8_SB(0, 0), cB, voffB); PG8_STAGE(PG8_SB(0, 1), cB + hstep, voffB); PG8_STAGE(PG8_SA(0, 0), cA, voffA); PG8_STAGE(PG8_SA(0, 1), cA + hstep, voffA);
        if (wr == 1) PG8_BAR;
        PG8_WAIT_V(2); PG8_BAR;
        PG8_STAGE(PG8_SB(1, 0), cB + kstep, voffB); PG8_STAGE(PG8_SA(1, 0), cA + kstep, voffA); PG8_STAGE(PG8_SB(1, 1), cB + hstep + kstep, voffB);
        PG8_WAIT_V(6); PG8_BAR;
    } else {
        PG8_STAGE(PG8_SB(0, 0), cB, voffB); PG8_STAGE(PG8_SA(0, 0), cA, voffA); PG8_STAGE(PG8_SB(0, 1), cB + hstep, voffB); PG8_STAGE(PG8_SA(0, 1), cA + hstep, voffA);
        if (wr == 1) PG8_BAR;
        PG8_WAIT_V(4); PG8_BAR;
        PG8_STAGE(PG8_SB(1, 0), cB + kstep, voffB); PG8_STAGE(PG8_SA(1, 0), cA + kstep, voffA); PG8_STAGE(PG8_SB(1, 1), cB + hstep + kstep, voffB);
        PG8_WAIT_V(6); PG8_BAR;
    }
    for (;;) {
        const bool has_next = S.next(ui + 1, nxt);
        const char* nA = has_next ? (const char*)g.A + (size_t)nxt.pm * tstep : cA; const char* nB = has_next ? (const char*)g.Bt + (size_t)nxt.pn * tstep : cB;
        for (int t = 0; t < nt; t += 2) {
            const bool last = (t == nt - 2);
            const char* a1 = cA + (size_t)(t + 1) * kstep;
            const char* a2 = last ? nA : cA + (size_t)(t + 2) * kstep; const char* b2 = last ? nB : cB + (size_t)(t + 2) * kstep;
            const char* a3 = a2 + kstep; const char* b3 = b2 + kstep;
            if (last && has_next) S.a_ready(nxt);
            if constexpr (Epi::MID) { if (t == nt / 2) { PG8_SCHED; E.mid(acc, cur, wr, wc, fr, fq); PG8_SCHED; } }
            if constexpr (SP2) {
            PG8_LDB(B0, 0, 0); PG8_LDB(B1, 0, 1); PG8_SCHED; PG8_LDA(At, 0, 0); PG8_STAGE(PG8_SA(1, 1), a1 + hstep, voffA);
            PG8_WAIT_V(8); PG8_WAIT_L(0); PG8_BAR; PG8_MMA(0, 0, At, B0); PG8_MMA(0, 1, At, B1); PG8_BAR; PG8_SCHED;
            PG8_LDA(At, 0, 1); PG8_STAGE(PG8_SB(0, 0), b2, voffB); PG8_STAGE(PG8_SB(0, 1), b2 + hstep, voffB); PG8_STAGE(PG8_SA(0, 0), a2, voffA);
            PG8_WAIT_V(8); PG8_WAIT_L(0); PG8_BAR; PG8_MMA(1, 0, At, B0); PG8_MMA(1, 1, At, B1); PG8_BAR; PG8_SCHED;
            PG8_LDB(B0, 1, 0); PG8_LDB(B1, 1, 1); PG8_SCHED; PG8_LDA(At, 1, 0); PG8_STAGE(PG8_SA(0, 1), a2 + hstep, voffA);
            PG8_WAIT_V(8); PG8_WAIT_L(0); PG8_BAR; PG8_MMA(0, 0, At, B0); PG8_MMA(0, 1, At, B1); PG8_BAR; PG8_SCHED;
            PG8_LDA(At, 1, 1); PG8_STAGE(PG8_SB(1, 0), b3, voffB); PG8_STAGE(PG8_SB(1, 1), b3 + hstep, voffB); PG8_STAGE(PG8_SA(1, 0), a3, voffA);
            PG8_WAIT_V(8); PG8_WAIT_L(0); PG8_BAR; PG8_MMA(1, 0, At, B0); PG8_MMA(1, 1, At, B1); PG8_BAR; PG8_SCHED;
            } else {
            PG8_LDB(B0, 0, 0); PG8_SCHED; PG8_LDA(At, 0, 0); PG8_STAGE(PG8_SA(1, 1), a1 + hstep, voffA);
            PG8_WAIT_L(8); PG8_BAR; PG8_WAIT_L(0); PG8_MMA(0, 0, At, B0); PG8_BAR; PG8_SCHED;
            PG8_LDB(B1, 0, 1); PG8_STAGE(PG8_SB(0, 0), b2, voffB);
            PG8_BAR; PG8_WAIT_L(0); PG8_MMA(0, 1, At, B1); PG8_BAR;
            PG8_LDA(At, 0, 1); PG8_STAGE(PG8_SA(0, 0), a2, voffA);
            PG8_BAR; PG8_WAIT_L(0); PG8_MMA(1, 0, At, B0); PG8_BAR; PG8_SCHED;
            PG8_STAGE(PG8_SB(0, 1), b2 + hstep, voffB);
            PG8_WAIT_V(6); PG8_BAR; PG8_MMA(1, 1, At, B1); PG8_BAR;
            PG8_LDB(B0, 1, 0); PG8_SCHED; PG8_LDA(At, 1, 0); PG8_STAGE(PG8_SA(0, 1), a2 + hstep, voffA);
            PG8_WAIT_L(8); PG8_BAR; PG8_WAIT_L(0); PG8_MMA(0, 0, At, B0); PG8_BAR; PG8_SCHED;
            PG8_LDB(B1, 1, 1); PG8_STAGE(PG8_SB(1, 0), b3, voffB);
            PG8_BAR; PG8_WAIT_L(0); PG8_MMA(0, 1, At, B1); PG8_BAR;
            PG8_LDA(At, 1, 1); PG8_STAGE(PG8_SA(1, 0), a3, voffA);
            PG8_BAR; PG8_WAIT_L(0); PG8_MMA(1, 0, At, B0); PG8_BAR; PG8_SCHED;
            PG8_STAGE(PG8_SB(1, 1), b3 + hstep, voffB);
            PG8_WAIT_V(6); PG8_BAR; PG8_MMA(1, 1, At, B1); PG8_BAR;
            }
        }
        if constexpr (ALIGN_EPI) { if (wr == 0) PG8_BAR; }
        if constexpr (!Epi::AFTER_DRAIN) { E(acc, cur, wr, wc, fr, fq); S.done(cur); }
        if (!has_next) break;
#pragma unroll
        for (int a = 0; a < 2; ++a)
#pragma unroll
            for (int b = 0; b < 2; ++b)
#pragma unroll
                for (int m = 0; m < 4; ++m)
#pragma unroll
                    for (int n = 0; n < 2; ++n) acc[a][b][m][n] = (f32x4){0.f, 0.f, 0.f, 0.f};
        cur = nxt; cA = nA; cB = nB; ++ui;
        if constexpr (ALIGN_EPI) { if (wr == 1) PG8_BAR; }
    }
    PG8_WAIT_V(0);
    if constexpr (!ALIGN_EPI) { if (wr == 0) PG8_BAR; }
    PG8_BAR;
    if constexpr (Epi::AFTER_DRAIN) { E.fused(acc, cur, wr, wc, fr, fq, lds, wid, lane); S.done(cur); }
#undef PG8_SA
#undef PG8_SB
#undef PG8_STAGE
#undef PG8_LDA
#undef PG8_LDB
#undef PG8_MMA
#undef PG8_WAIT_V
#undef PG8_WAIT_L
#undef PG8_BAR
#undef PG8_SCHED
}
}

#define LAS __attribute__((address_space(3)))
typedef unsigned short bf16;
typedef unsigned v4u __attribute__((ext_vector_type(4)));
typedef unsigned v2u __attribute__((ext_vector_type(2)));
typedef float f32x4 __attribute__((ext_vector_type(4)));
typedef short bf16x8 __attribute__((ext_vector_type(8)));
using pg8::cvt_pk_bf16; using pg8::bflo; using pg8::bfhi; using pg8::fexp2; using pg8::frcp;

constexpr int NWAVES = 8;
constexpr int SEQ = 2048, M = 32768, D = 1024, INW = 3840, DFF = 2816, NUP = 5632;
constexpr int PP = 2944;
constexpr int C_K = 512, C_V = 640, C_SU = 768, C_SV = 1280;
constexpr float EPS = 1e-6f, LOG2E = 1.4426950408889634f;
constexpr size_t MiB = (size_t)1 << 20;
constexpr size_t O_WIN = 0, O_WAB = O_WIN + (size_t)INW * D * 2, O_WOUT = O_WAB + 2 * MiB, O_WUP = O_WOUT + 2 * MiB, O_WDN = O_WUP + (size_t)NUP * D * 2, O_WSG = O_WDN + (size_t)D * DFF * 2, LSTRIDE = O_WSG + MiB / 4 + MiB / 4;
constexpr size_t WS_H = 2 * LSTRIDE, WS_Y = WS_H + 64 * MiB, WS_P = WS_Y + 64 * MiB, WS_HALO = WS_P + 240 * MiB, WS_CTL = WS_HALO + (size_t)512 * 4 * NUP * 4, WS_PS = WS_CTL + 16384, CTL_ZERO_BYTES = 16384 + 4 * (size_t)M * 4, WS_CWB = WS_CTL + CTL_ZERO_BYTES, WS_END = WS_CWB + (size_t)2 * 4 * NUP * 2;
constexpr int LDS_BYTES = 144 * 1024;
static_assert(LSTRIDE % 256 == 0 && WS_END <= 512 * MiB, "workspace map");

__device__ __forceinline__ float wave_sum(float v) {
#pragma unroll
    for (int o = 1; o < 64; o <<= 1) v += __shfl_xor(v, o);
    return v;
}
template <int UPMAP  >
__device__ __forceinline__ void cvt_item(const float* W, int N, bf16* WT, int ldk, int koff, LAS float* scr, int item, int lane, const float* gain = nullptr) {
    const int nblk = N / 32, kb = item / nblk, nb = item % nblk, k0 = 64 * kb, n0 = 32 * nb;
    float wv[32];
#pragma unroll
    for (int i = 0; i < 32; ++i) { const int kk = 2 * i + (lane >> 5); wv[i] = __builtin_nontemporal_load(W + (size_t)(k0 + kk) * N + n0 + (lane & 31)); }
    if (gain) {
#pragma unroll
        for (int i = 0; i < 32; ++i) wv[i] *= gain[k0 + 2 * i + (lane >> 5)]; }
#pragma unroll
    for (int i = 0; i < 32; ++i) { const int kk = 2 * i + (lane >> 5); scr[kk * 33 + (lane & 31)] = wv[i]; }
    asm volatile("s_waitcnt lgkmcnt(0)" ::: "memory");
    const int c = lane & 7;
#pragma unroll
    for (int j = 0; j < 4; ++j) { const int n = (lane >> 3) + 8 * j; const LAS float* s = scr + (8 * c) * 33 + n;
        v4u o; o.x = cvt_pk_bf16(s[0 * 33], s[1 * 33]); o.y = cvt_pk_bf16(s[2 * 33], s[3 * 33]); o.z = cvt_pk_bf16(s[4 * 33], s[5 * 33]); o.w = cvt_pk_bf16(s[6 * 33], s[7 * 33]);
        int row = n0 + n;
        if (UPMAP == 1) { const int f = row < DFF ? row : row - DFF; row = (f >> 7) * 256 + (row < DFF ? 0 : 128) + (f & 127); }
        if (UPMAP == 2) { if (row >= 1792) { const int gi = row - 1792, c = gi & 1023; row = 1792 + (c >> 7) * 256 + (gi < 1024 ? 0 : 128) + (c & 127); } }
        *(v4u*)(WT + (size_t)row * ldk + koff + k0 + 8 * c) = o; }
    asm volatile("s_waitcnt lgkmcnt(0)" ::: "memory");
}
template <class A> __device__ __forceinline__ void p0_convert(const A& a, LAS unsigned char* lds, int gw, int NGW, int wave, int lane) {
    LAS float* scr = (LAS float*)(lds + wave * 8448);
    constexpr int I_IN = (D / 64) * (INW / 32), I_OA = (512 / 64) * (D / 32), I_OUT = (D / 64) * (D / 32), I_UP = (D / 64) * (NUP / 32), I_DN = (DFF / 64) * (D / 32);
    constexpr int PER_L = I_IN + 2 * I_OA + I_OUT + I_UP + I_DN;
    for (int it = gw; it < 2 * PER_L; it += NGW) {
        const int l = it / PER_L; int r = it % PER_L; unsigned char* wl = a.ws + (size_t)l * LSTRIDE;
        if (r < I_IN) { cvt_item<2>(a.in[2] + (size_t)l * D * INW, INW, (bf16*)(wl + O_WIN), D, 0, scr, r, lane, a.in[1] + l * D); continue; } r -= I_IN;
        if (r < I_OA) { cvt_item<0>(a.in[9] + (size_t)l * 512 * D, D, (bf16*)(wl + O_WAB), D, 0, scr, r, lane); continue; } r -= I_OA;
        if (r < I_OA) { cvt_item<0>(a.in[10] + (size_t)l * 512 * D, D, (bf16*)(wl + O_WAB), D, 512, scr, r, lane); continue; } r -= I_OA;
        if (r < I_OUT) { cvt_item<0>(a.in[11] + (size_t)l * D * D, D, (bf16*)(wl + O_WOUT), D, 0, scr, r, lane); continue; } r -= I_OUT;
        if (r < I_UP) { cvt_item<1>(a.in[13] + (size_t)l * D * NUP, NUP, (bf16*)(wl + O_WUP), D, 0, scr, r, lane, a.in[12] + l * D); continue; } r -= I_UP;
        cvt_item<0>(a.in[16] + (size_t)l * DFF * D, D, (bf16*)(wl + O_WDN), DFF, 0, scr, r, lane);
    }
    for (int e = gw * 64 + lane; e < 2 * 4 * NUP; e += NGW * 64) { const int l = e / (4 * NUP), k = (e / NUP) & 3, c = e % NUP;
        const float w = (k < 3) ? a.in[14][(size_t)l * 3 * NUP + (size_t)k * NUP + c] : a.in[15][(size_t)l * NUP + c]; ((bf16*)(a.ws + WS_CWB))[e] = (bf16)(cvt_pk_bf16(w, 0.f) & 0xffffu); }
    for (int e = gw * 64 + lane; e < 2 * 8 * 128 * 128; e += NGW * 64) { const int l = e >> 17, r = e & 131071, i = (r >> 7) & 127, j = r & 127;
        const float w = a.in[7][e]; ((bf16*)(a.ws + (size_t)l * LSTRIDE + O_WSG))[r] = (bf16)(cvt_pk_bf16(j <= i ? w : 0.f, 0.f) & 0xffffu); }
}
__device__ __forceinline__ void xb_phase(const float* x, bf16* h, float* PS, int gw, int NGW, int lane) {
    for (int row = gw; row < M; row += NGW) {
        const f32x4* xr = (const f32x4*)(x + (size_t)row * D) + lane; f32x4 v[4]; float s = 0.f;
#pragma unroll
        for (int j = 0; j < 4; ++j) { v[j] = __builtin_nontemporal_load(xr + 64 * j); s += (v[j].x * v[j].x + v[j].y * v[j].y) + (v[j].z * v[j].z + v[j].w * v[j].w); }
        s = wave_sum(s);
        v2u* o = (v2u*)(h + (size_t)row * D) + lane;
#pragma unroll
        for (int j = 0; j < 4; ++j) { v2u w; w.x = cvt_pk_bf16(v[j].x, v[j].y); w.y = cvt_pk_bf16(v[j].z, v[j].w); o[64 * j] = w; }
        if (lane == 0) PS[row] = s;
    }
}
__device__ __forceinline__ void attn_item(LAS unsigned char* lds, const bf16* P, bf16* Y, const float* qg, const float* kg, const float* sinks, int item, int tid) {
    const int hkv = item & 1, nb = (item >> 1) & 15, b = item >> 5;
    const int R0 = b * SEQ + nb * 128;
    LAS bf16* Ks = (LAS bf16*)lds; LAS bf16* Vt = (LAS bf16*)(lds + 36864);
    v4u qraw[4][2];
    { const int w_ = tid >> 6, ln = tid & 63; const bf16* qp = P + (size_t)(R0 + (w_ & 1) * 64 + (ln & 15)) * PP + (hkv * 4 + (w_ >> 1)) * 64 + 8 * (ln >> 4);
#pragma unroll
      for (int it = 0; it < 4; ++it) { qraw[it][0] = *(const v4u*)(qp + (size_t)(16 * it) * PP); qraw[it][1] = *(const v4u*)(qp + (size_t)(16 * it) * PP + 32); } }
#pragma unroll
    for (int i = 0; i < 4; ++i) {
        const int task = tid + 512 * i, key = task >> 3, c = task & 7; const bool ok = (nb > 0) || (key >= 128);
        v4u kr = {0u, 0u, 0u, 0u}, vr = {0u, 0u, 0u, 0u};
        if (ok) { const bf16* rp = P + (size_t)(R0 - 128 + key) * PP + hkv * 64 + 8 * c; kr = *(const v4u*)(rp + C_K); vr = *(const v4u*)(rp + C_V); }
        float kf[8];
#pragma unroll
        for (int e = 0; e < 4; ++e) { kf[2 * e] = bflo(kr[e]); kf[2 * e + 1] = bfhi(kr[e]); }
        float ss = 0.f;
#pragma unroll
        for (int e = 0; e < 8; ++e) ss += kf[e] * kf[e];
        ss += __shfl_xor(ss, 1); ss += __shfl_xor(ss, 2); ss += __shfl_xor(ss, 4);
        const float rs = rsqrtf(ss * (1.f / 64.f) + EPS);
        const f32x4 g0 = *(const f32x4*)(kg + 8 * c), g1 = *(const f32x4*)(kg + 8 * c + 4);
        v4u kw; kw.x = cvt_pk_bf16(kf[0] * rs * g0.x, kf[1] * rs * g0.y); kw.y = cvt_pk_bf16(kf[2] * rs * g0.z, kf[3] * rs * g0.w);
        kw.z = cvt_pk_bf16(kf[4] * rs * g1.x, kf[5] * rs * g1.y); kw.w = cvt_pk_bf16(kf[6] * rs * g1.z, kf[7] * rs * g1.w);
        *(LAS v4u*)(Ks + key * 72 + 8 * c) = kw;
#pragma unroll
        for (int e = 0; e < 4; ++e) { Vt[(8 * c + 2 * e) * 264 + key] = (bf16)(vr[e] & 0xffffu); Vt[(8 * c + 2 * e + 1) * 264 + key] = (bf16)(vr[e] >> 16); }
    }
    __syncthreads();
    const int w = tid >> 6, lane = tid & 63, fr = lane & 15, fq = lane >> 4, g = w >> 1, h = hkv * 4 + g, half = w & 1;
    const float slope2 = exp2f(-(float)(h + 1)) * LOG2E, sink2 = sinks[h] * LOG2E;
    f32x4 qgv[4];
#pragma unroll
    for (int ks = 0; ks < 2; ++ks) { qgv[2 * ks] = *(const f32x4*)(qg + 32 * ks + 8 * fq); qgv[2 * ks + 1] = *(const f32x4*)(qg + 32 * ks + 8 * fq + 4); }
    const int d0i = fr + 128 - 4 * fq; const float t0 = -slope2 * (float)d0i;
    float be[2][4];
#pragma unroll
    for (int r = 0; r < 4; ++r) { const int da = d0i - r, db8 = d0i - 128 - r; be[0][r] = (da < 128) ? -slope2 * (float)da : -1e30f; be[1][r] = (db8 >= 0) ? -slope2 * (float)db8 : -1e30f; }
#pragma unroll 1
    for (int it = 0; it < 4; ++it) {
        const int qb = half * 4 + it, i0 = 16 * qb;
        const v4u q0 = qraw[0][0], q1 = qraw[0][1];
#pragma unroll
        for (int k = 0; k < 3; ++k) { qraw[k][0] = qraw[k + 1][0]; qraw[k][1] = qraw[k + 1][1]; }
        float qf[16];
#pragma unroll
        for (int e = 0; e < 4; ++e) { qf[2 * e] = bflo(q0[e]); qf[2 * e + 1] = bfhi(q0[e]); qf[8 + 2 * e] = bflo(q1[e]); qf[8 + 2 * e + 1] = bfhi(q1[e]); }
        float ss = 0.f;
#pragma unroll
        for (int e = 0; e < 16; ++e) ss += qf[e] * qf[e];
        ss += __shfl_xor(ss, 16); ss += __shfl_xor(ss, 32);
        const float rs = rsqrtf(ss * (1.f / 64.f) + EPS) * (0.125f * LOG2E);
        bf16x8 qa[2];
#pragma unroll
        for (int ks = 0; ks < 2; ++ks) { v4u t;
            t.x = cvt_pk_bf16(qf[8 * ks + 0] * rs * qgv[2 * ks].x, qf[8 * ks + 1] * rs * qgv[2 * ks].y); t.y = cvt_pk_bf16(qf[8 * ks + 2] * rs * qgv[2 * ks].z, qf[8 * ks + 3] * rs * qgv[2 * ks].w);
            t.z = cvt_pk_bf16(qf[8 * ks + 4] * rs * qgv[2 * ks + 1].x, qf[8 * ks + 5] * rs * qgv[2 * ks + 1].y); t.w = cvt_pk_bf16(qf[8 * ks + 6] * rs * qgv[2 * ks + 1].z, qf[8 * ks + 7] * rs * qgv[2 * ks + 1].w);
            qa[ks] = __builtin_bit_cast(bf16x8, t); }
        f32x4 sc[9];
#pragma unroll
        for (int k9 = 0; k9 < 9; ++k9) { f32x4 accs = {0.f, 0.f, 0.f, 0.f};
#pragma unroll
            for (int ks = 0; ks < 2; ++ks) { const bf16x8 kfr = *(const LAS bf16x8*)(Ks + (16 * (qb + k9) + fr) * 72 + 32 * ks + 8 * fq); accs = __builtin_amdgcn_mfma_f32_16x16x32_bf16(kfr, qa[ks], accs, 0, 0, 0); }
            sc[k9] = accs; }
        float mx = sink2;
#pragma unroll
        for (int k9 = 0; k9 < 9; ++k9) { const bool nokey = (nb == 0) && (qb + k9 < 8);
#pragma unroll
            for (int r = 0; r < 4; ++r) {
                float s = (k9 == 0) ? sc[k9][r] + be[0][r] : (k9 == 8) ? sc[k9][r] + be[1][r] : sc[k9][r] + __builtin_fmaf(slope2, (float)(16 * k9 + r), t0);
                s = nokey ? -1e30f : s; sc[k9][r] = s; mx = fmaxf(mx, s); } }
        mx = fmaxf(mx, __shfl_xor(mx, 16)); mx = fmaxf(mx, __shfl_xor(mx, 32));
        float l = 0.f;
#pragma unroll
        for (int k9 = 0; k9 < 9; ++k9)
#pragma unroll
            for (int r = 0; r < 4; ++r) { const float p = fexp2(sc[k9][r] - mx); sc[k9][r] = p; l += p; }
        l += __shfl_xor(l, 16); l += __shfl_xor(l, 32);
        const float inv = 1.0f / (l + fexp2(sink2 - mx));
        f32x4 o[4];
#pragma unroll
        for (int db = 0; db < 4; ++db) o[db] = (f32x4){0.f, 0.f, 0.f, 0.f};
#pragma unroll
        for (int gp = 0; gp < 5; ++gp) {
            v4u t; t.x = cvt_pk_bf16(sc[2 * gp][0] * inv, sc[2 * gp][1] * inv); t.y = cvt_pk_bf16(sc[2 * gp][2] * inv, sc[2 * gp][3] * inv);
            if (gp < 4) { t.z = cvt_pk_bf16(sc[2 * gp + 1][0] * inv, sc[2 * gp + 1][1] * inv); t.w = cvt_pk_bf16(sc[2 * gp + 1][2] * inv, sc[2 * gp + 1][3] * inv); } else { t.z = 0u; t.w = 0u; }
            const bf16x8 pf = __builtin_bit_cast(bf16x8, t);
            const int kb0 = qb + 2 * gp, kb1 = (gp < 4) ? kb0 + 1 : kb0;
#pragma unroll
            for (int db = 0; db < 4; ++db) { const LAS bf16* vp = Vt + (16 * db + fr) * 264 + 4 * fq;
                const v2u va = *(const LAS v2u*)(vp + 16 * kb0), vb = *(const LAS v2u*)(vp + 16 * kb1);
                v4u vv; vv.x = va.x; vv.y = va.y; vv.z = vb.x; vv.w = vb.y;
                o[db] = __builtin_amdgcn_mfma_f32_16x16x32_bf16(__builtin_bit_cast(bf16x8, vv), pf, o[db], 0, 0, 0); }
        }
        bf16* yp = Y + (size_t)(R0 + i0 + fr) * D + h * 64 + 4 * fq;
#pragma unroll
        for (int db = 0; db < 4; ++db) { v2u wv; wv.x = cvt_pk_bf16(o[db][0], o[db][1]); wv.y = cvt_pk_bf16(o[db][2], o[db][3]); *(v2u*)(yp + 16 * db) = wv; }
    }
    __syncthreads();
}
__device__ __forceinline__ void sgu_item(LAS unsigned char* lds, const bf16* P, bf16* Y, const float* gain, const bf16* Wsb, const float* bs, int item, int tid) {
    const int R0 = item * 128;
    const int g = __builtin_amdgcn_readfirstlane(tid >> 6), lane = tid & 63, fr = lane & 15, fq = lane >> 4;
    LAS float* part = (LAS float*)lds;
    LAS bf16* Vt = (LAS bf16*)(lds + 4096) + g * (64 * 136);
    v4u r[2][8];
#pragma unroll
    for (int p = 0; p < 2; ++p) { const bf16* rp = P + (size_t)(R0 + 2 * lane + p) * PP + C_SV + g * 64;
#pragma unroll
        for (int c = 0; c < 8; ++c) r[p][c] = *(const v4u*)(rp + 8 * c); }
    const bf16* Wg = Wsb + g * 16384;
#pragma unroll
    for (int p = 0; p < 2; ++p) { float ss = 0.f;
#pragma unroll
        for (int c = 0; c < 8; ++c)
#pragma unroll
            for (int e = 0; e < 4; ++e) { const float a0 = bflo(r[p][c][e]), a1 = bfhi(r[p][c][e]); ss += a0 * a0 + a1 * a1; }
        part[g * 128 + 2 * lane + p] = ss; }
    __syncthreads();
    float rs[2];
#pragma unroll
    for (int p = 0; p < 2; ++p) { float t = 0.f;
#pragma unroll
        for (int q = 0; q < 8; ++q) t += part[q * 128 + 2 * lane + p];
        rs[p] = rsqrtf(t * (1.f / 512.f) + EPS); }
#pragma unroll
    for (int c = 0; c < 8; ++c)
#pragma unroll
        for (int e = 0; e < 4; ++e) {
            const unsigned w0 = cvt_pk_bf16(bflo(r[0][c][e]) * rs[0], bflo(r[1][c][e]) * rs[1]), w1 = cvt_pk_bf16(bfhi(r[0][c][e]) * rs[0], bfhi(r[1][c][e]) * rs[1]);
            *(LAS unsigned*)(Vt + (8 * c + 2 * e) * 136 + 2 * lane) = w0; *(LAS unsigned*)(Vt + (8 * c + 2 * e + 1) * 136 + 2 * lane) = w1; }
    f32x4 gn[4];
#pragma unroll
    for (int db = 0; db < 4; ++db) gn[db] = *(const f32x4*)(gain + g * 64 + 16 * db + 4 * fq);
    __syncthreads();
    bf16x8 wfr[8][4]; v2u sur[8][4]; float bia[8];
#pragma unroll
    for (int ib = 0; ib < 8; ++ib) { const bf16* wp = Wg + (16 * ib + fr) * 128 + 8 * fq;
#pragma unroll
        for (int ks = 0; ks < 4; ++ks) if (ks <= (ib >> 1)) wfr[ib][ks] = *(const bf16x8*)(wp + 32 * ks);
        const bf16* up = P + (size_t)(R0 + 16 * ib + fr) * PP + C_SU + g * 64 + 4 * fq;
#pragma unroll
        for (int db = 0; db < 4; ++db) sur[ib][db] = *(const v2u*)(up + 16 * db);
        bia[ib] = bs[g * 128 + 16 * ib + fr]; }
#pragma unroll
    for (int ib = 0; ib < 8; ++ib) {
        f32x4 acc[4];
#pragma unroll
        for (int db = 0; db < 4; ++db) acc[db] = (f32x4){0.f, 0.f, 0.f, 0.f};
#pragma unroll
        for (int ks = 0; ks < 4; ++ks) if (ks <= (ib >> 1)) {
#pragma unroll
            for (int db = 0; db < 4; ++db) { const bf16x8 vf = *(const LAS bf16x8*)(Vt + (16 * db + fr) * 136 + 32 * ks + 8 * fq); acc[db] = __builtin_amdgcn_mfma_f32_16x16x32_bf16(vf, wfr[ib][ks], acc[db], 0, 0, 0); } }
        bf16* yp = Y + (size_t)(R0 + 16 * ib + fr) * D + 512 + g * 64 + 4 * fq; const float bias = bia[ib];
#pragma unroll
        for (int db = 0; db < 4; ++db) {
            v2u wv; wv.x = cvt_pk_bf16(bflo(sur[ib][db].x) * (acc[db][0] * gn[db][0] + bias), bfhi(sur[ib][db].x) * (acc[db][1] * gn[db][1] + bias));
            wv.y = cvt_pk_bf16(bflo(sur[ib][db].y) * (acc[db][2] * gn[db][2] + bias), bfhi(sur[ib][db].y) * (acc[db][3] * gn[db][3] + bias));
            *(v2u*)(yp + 16 * db) = wv; }
    }
    __syncthreads();
}
__device__ __forceinline__ void fixup_phase(const bf16* halo, const float* cw, const float* cb, bf16* act, int gtid, int nthreads) {
    for (int e = gtid; e < 512 * (DFF / 4); e += nthreads) {
        const int s = e / (DFF / 4), f = (e % (DFF / 4)) * 4; const bool first = (s & 31) == 0;
        const bf16* hs = halo + (size_t)s * 4 * NUP; const bf16* hpv = hs - (size_t)4 * NUP;
        float r0[4], r1[4];
#pragma unroll
        for (int half = 0; half < 2; ++half) { const int col = f + half * DFF; const v2u a0 = *(const v2u*)(hs + col), a1 = *(const v2u*)(hs + NUP + col);
            v2u am2 = {0u, 0u}, am1 = am2; if (!first) { am2 = *(const v2u*)(hpv + 2 * NUP + col); am1 = *(const v2u*)(hpv + 3 * NUP + col); }
            const f32x4 z0 = {bflo(a0.x), bfhi(a0.x), bflo(a0.y), bfhi(a0.y)}, z1 = {bflo(a1.x), bfhi(a1.x), bflo(a1.y), bfhi(a1.y)};
            const f32x4 zm2 = {bflo(am2.x), bfhi(am2.x), bflo(am2.y), bfhi(am2.y)}, zm1 = {bflo(am1.x), bfhi(am1.x), bflo(am1.y), bfhi(am1.y)};
            const f32x4 w0 = *(const f32x4*)(cw + col), w1 = *(const f32x4*)(cw + NUP + col), w2 = *(const f32x4*)(cw + 2 * NUP + col), bb = *(const f32x4*)(cb + col);
            const f32x4 c0 = bb + w0 * zm2 + w1 * zm1 + w2 * z0, c1 = bb + w0 * zm1 + w1 * z0 + w2 * z1;
#pragma unroll
            for (int j = 0; j < 4; ++j) { if (half == 0) { r0[j] = c0[j] * frcp(1.0f + fexp2(-LOG2E * c0[j])); r1[j] = c1[j] * frcp(1.0f + fexp2(-LOG2E * c1[j])); } else { r0[j] *= c0[j]; r1[j] *= c1[j]; } } }
        v2u o0, o1; o0.x = cvt_pk_bf16(r0[0], r0[1]); o0.y = cvt_pk_bf16(r0[2], r0[3]); o1.x = cvt_pk_bf16(r1[0], r1[1]); o1.y = cvt_pk_bf16(r1[2], r1[3]);
        *(v2u*)(act + (size_t)(64 * s) * DFF + f) = o0; *(v2u*)(act + (size_t)(64 * s + 1) * DFF + f) = o1;
    }
}

#ifndef PHM
#define PHM 511
#endif
#define XB_TMO      128
#define XB_XCNT(j)  (256  + 64 * (j))
#define XB_XSUB(j)  (1280 + 64 * (j))
#define XB_XGEN(j)  (2304 + 64 * (j))
#define XB_TOP      3328
#define XB_TOPGEN   3392
#define XCD_BAR_WORDS 3456
#define XB_SPIN_CAP (1u << 18)
__device__ __forceinline__ unsigned xb_ld(unsigned* p)              { return __hip_atomic_load(p, __ATOMIC_RELAXED, __HIP_MEMORY_SCOPE_AGENT); }
__device__ __forceinline__ unsigned xb_add(unsigned* p, unsigned v) { return __hip_atomic_fetch_add(p, v, __ATOMIC_RELAXED, __HIP_MEMORY_SCOPE_AGENT); }
__device__ __forceinline__ unsigned xb_xcc_id() { return (unsigned)__builtin_amdgcn_s_getreg((3 << 11) | 20) & 0xFu; }
#define XB_SPIN(cond, bar) do { unsigned _sp = 0; while (cond) { __builtin_amdgcn_s_sleep(1); \
    if ((++_sp & 255u) == 0u) { if (xb_ld(&(bar)[XB_TMO])) break; if (_sp > XB_SPIN_CAP) { atomicAdd(&(bar)[XB_TMO], 1u); break; } } } } while (0)
struct XcdBarrier { unsigned* bar; unsigned x; volatile LAS unsigned* st; };
__device__ __forceinline__ XcdBarrier xcd_barrier_post(unsigned* bar, volatile LAS unsigned* st) {
    XcdBarrier b; b.bar = bar; b.x = xb_xcc_id(); b.st = st;
    if (threadIdx.x == 0) (void)xb_add(&bar[XB_XCNT(b.x)], 1u);
    return b;
}
__device__ __forceinline__ void xcd_barrier_complete(unsigned* bar, unsigned x, unsigned& nloc, unsigned& nx) {
    const unsigned G = gridDim.x * gridDim.y * gridDim.z;
    unsigned sum, cnt, mine, sp = 0u;
    for (;;) {
        sum = 0u; cnt = 0u; mine = 0u;
#pragma unroll
        for (unsigned j = 0; j < 16; ++j) { const unsigned c = xb_ld(&bar[XB_XCNT(j)]); sum += c; cnt += (c > 0u) ? 1u : 0u; mine = (j == x) ? c : mine; }
        if (sum == G) break;
        __builtin_amdgcn_s_sleep(1);
        if ((++sp & 255u) == 0u) { if (xb_ld(&bar[XB_TMO])) break; if (sp > XB_SPIN_CAP) { atomicAdd(&bar[XB_TMO], 1u); break; } }
    }
    nloc = mine > 0u ? mine : 1u; nx = cnt > 0u ? cnt : 1u;
}
__device__ __forceinline__ void xcd_barrier(const XcdBarrier& b) {
    asm volatile("s_waitcnt vmcnt(0)" ::: "memory");
    __syncthreads();
    if (threadIdx.x == 0) {
        unsigned* bar = b.bar;
        __builtin_amdgcn_s_waitcnt(0);
        unsigned nloc = b.st[0], nx = b.st[1];
        if (nloc == 0u) { xcd_barrier_complete(bar, b.x, nloc, nx); b.st[0] = nloc; b.st[1] = nx; }
        const unsigned old = xb_add(&bar[XB_XSUB(b.x)], 1u);
        const unsigned gen = old / nloc;
        if (old + 1u == (gen + 1u) * nloc) {
            __builtin_amdgcn_fence(__ATOMIC_RELEASE, "agent");
            asm volatile("s_waitcnt vmcnt(0)" ::: "memory");
            const unsigned og = xb_add(&bar[XB_TOP], 1u);
            const unsigned tg = og / nx;
            if (og + 1u == (tg + 1u) * nx) xb_add(&bar[XB_TOPGEN], 1u);
            else XB_SPIN(xb_ld(&bar[XB_TOPGEN]) == tg, bar);
            __builtin_amdgcn_fence(__ATOMIC_ACQUIRE, "agent");
            xb_add(&bar[XB_XGEN(b.x)], 1u);
            asm volatile("s_waitcnt vmcnt(0)" ::: "memory");
        } else {
            XB_SPIN(xb_ld(&bar[XB_XGEN(b.x)]) == gen, bar);
            __builtin_amdgcn_fence(__ATOMIC_ACQUIRE, "agent");
            asm volatile("s_waitcnt vmcnt(0)" ::: "memory");
        }
    }
    __syncthreads();
}
#ifndef PROBE_DOUBLE
#define PROBE_DOUBLE 0
#endif
#ifndef PROBE_SYNCS
#define PROBE_SYNCS 0
#endif
struct Args { const float* in[17]; float* out; unsigned char* ws; int ph_lo, ph_hi; };
constexpr int N_PHASES = 15;
__global__ void __launch_bounds__(NWAVES * 64, 2) fwd_kernel(Args args) {
    extern __shared__ __attribute__((aligned(16))) unsigned char lds_raw[];
    LAS unsigned char* lds = (LAS unsigned char*)lds_raw;
    cg::grid_group grid = cg::this_grid();
    if (threadIdx.x < 4) ((LAS unsigned*)(lds + LDS_BYTES - 16))[threadIdx.x] = 0u;
    __syncthreads();
    XcdBarrier xb = xcd_barrier_post((unsigned*)(args.ws + WS_CTL), (volatile LAS unsigned*)(lds + LDS_BYTES - 16));
    const Args& a = args;
    bf16* const Hb = (bf16*)(a.ws + WS_H); bf16* const Yb = (bf16*)(a.ws + WS_Y); bf16* const Pb = (bf16*)(a.ws + WS_P); bf16* const halo = (bf16*)(a.ws + WS_HALO); bf16* const Xb = (bf16*)a.out;     float* const PS = (float*)(a.ws + WS_PS);
#pragma unroll 1
    for (int ph = args.ph_lo; ph < args.ph_hi; ++ph) {
      const int nrep = ((PROBE_DOUBLE >> (ph == 0 ? 9 : (ph - 1) % 7)) & 1) ? 2 : 1;
#pragma unroll 1
      for (int rep = 0; rep < nrep; ++rep) {
        int tid = threadIdx.x; asm volatile("" : "+v"(tid));
        int bid = blockIdx.x; asm volatile("" : "+s"(bid));
        const int lane = tid & 63, wave = __builtin_amdgcn_readfirstlane(tid >> 6);
        const int G = gridDim.x, gw = bid * NWAVES + wave, NGW = G * NWAVES;
        if (ph == 0) { if (PHM & 1) { p0_convert(a, lds, gw, NGW, wave, lane); xb_phase(a.in[0], Hb, PS, gw, NGW, lane); } }
        else {
            const int l = (ph - 1) / 7, sp = (ph - 1) % 7; unsigned char* wl = a.ws + (size_t)l * LSTRIDE;
            const bf16* Ain = (l == 0) ? Hb : Xb;
            if (sp == 0 && (PHM & 4)) { pg8::Gemm g{Ain, (const bf16*)(wl + O_WIN), M, INW, D}; pg8::Gemm1Order S; S.init(M, INW, G, bid); pg8::EpiProj E{Pb, PP, PS + (size_t)(2 * l) * M};
                pg8::gemm_phase<pg8::EpiProj, pg8::Gemm1Order, true, true>(lds, g, S, E, tid); }
            else if (sp == 1 && (PHM & 8)) {
                for (int it = bid; it < 768; it += G) {
                    if (it < 512) attn_item(lds, Pb, Yb, a.in[3] + l * 64, a.in[4] + l * 64, a.in[5] + l * 8, it, tid);
                    else sgu_item(lds, Pb, Yb, a.in[6] + l * 512, (const bf16*)(wl + O_WSG), a.in[8] + l * 1024, it - 512, tid);
                } }
            else if (sp == 2 && (PHM & 16)) { pg8::Gemm g{Yb, (const bf16*)(wl + O_WAB), M, D, D}; pg8::StaticOrder S; S.init(M, D, G, bid); pg8::EpiMerge E{Pb, Hb};
                pg8::gemm_phase<pg8::EpiMerge, pg8::StaticOrder, true, true>(lds, g, S, E, tid); }
            else if (sp == 3 && (PHM & 32)) { pg8::Gemm g{Hb, (const bf16*)(wl + O_WOUT), M, D, D}; pg8::StaticOrder S; S.init(M, D, G, bid); pg8::EpiResid E{(l == 0) ? a.in[0] : (const float*)nullptr, Xb, (float*)nullptr, Yb, PS + (size_t)(2 * l + 1) * M, D};
                pg8::gemm_phase<pg8::EpiResid, pg8::StaticOrder, true, true>(lds, g, S, E, tid); }
            else if (sp == 4 && (PHM & 64)) { pg8::Gemm g{Yb, (const bf16*)(wl + O_WUP), M, NUP, D}; pg8::StaticOrder S; S.init(M, NUP, G, bid); pg8::EpiConv E{(const bf16*)(a.ws + WS_CWB) + (size_t)l * 4 * NUP, Pb, halo, PS + (size_t)(2 * l + 1) * M};
                pg8::gemm_phase<pg8::EpiConv, pg8::StaticOrder, true, true>(lds, g, S, E, tid); }
            else if (sp == 5) { if (PHM & 128) fixup_phase(halo, a.in[14] + (size_t)l * 3 * NUP, a.in[15] + (size_t)l * NUP, Pb, bid * 512 + tid, G * 512); }
            else if (sp == 6 && (PHM & 256)) { pg8::Gemm g{Pb, (const bf16*)(wl + O_WDN), M, D, DFF}; pg8::StaticOrder S; S.init(M, D, G, bid); pg8::EpiResid E{(const float*)nullptr, Yb, (l == 0) ? (float*)nullptr : a.out, Xb, PS + (size_t)2 * M, D};
                pg8::gemm_phase<pg8::EpiResid, pg8::StaticOrder, true, true>(lds, g, S, E, tid); }
        }
        if (ph + 1 < args.ph_hi || rep + 1 < nrep) { if (args.ph_hi > 1000) grid.sync(); else xcd_barrier(xb); } else __syncthreads();
        for (int e = 0; e < PROBE_SYNCS; ++e) xcd_barrier(xb);
      }
    }
}

#ifndef MK_PER_PHASE
#define MK_PER_PHASE 0
#endif
extern "C" void kernel_launch(void* const* d_in, const int* in_sizes, int n_in, void* d_out, int out_size, void* d_ws, size_t ws_size, hipStream_t stream) {
    static int grid = 0;
    if (grid == 0) {
        if (n_in != 17 || out_size != M * D || ws_size < WS_END) { fprintf(stderr, "kernel_launch: unexpected shapes (n_in %d out %d ws %zu, need %zu)\n", n_in, out_size, ws_size, (size_t)WS_END); grid = -1; return; }
        int dev = 0, cus = 0, per_cu = 0;
        hipGetDevice(&dev); hipDeviceGetAttribute(&cus, hipDeviceAttributeMultiprocessorCount, dev);
        if (hipFuncSetAttribute((const void*)fwd_kernel, hipFuncAttributeMaxDynamicSharedMemorySize, LDS_BYTES) != hipSuccess) { fprintf(stderr, "kernel_launch: hipFuncSetAttribute failed\n"); grid = -1; return; }
        if (hipOccupancyMaxActiveBlocksPerMultiprocessor(&per_cu, (const void*)fwd_kernel, NWAVES * 64, LDS_BYTES) != hipSuccess || per_cu < 1) { fprintf(stderr, "kernel_launch: occupancy query says %d\n", per_cu); per_cu = 1; }
        (void)hipGetLastError();
        grid = cus * 1;
        fprintf(stderr, "kernel_launch: grid %d (cus %d, per_cu %d)\n", grid, cus, per_cu);
    }
    if (grid < 0) return;
    if (hipMemsetAsync((char*)d_ws + WS_CTL, 0, CTL_ZERO_BYTES, stream) != hipSuccess) { fprintf(stderr, "kernel_launch: memset failed\n"); return; }
    Args a{};
    for (int i = 0; i < 17; ++i) a.in[i] = (const float*)d_in[i];
    a.out = (float*)d_out; a.ws = (unsigned char*)d_ws;
#if MK_PER_PHASE
    for (int ph = 0; ph < N_PHASES; ++ph) { a.ph_lo = ph; a.ph_hi = ph + 1; hipLaunchKernelGGL(fwd_kernel, dim3(grid), dim3(NWAVES * 64), LDS_BYTES, stream, a); }
#else
    a.ph_lo = 0; a.ph_hi = N_PHASES;
    void* kargs[] = {&a};
    hipError_t e = hipLaunchCooperativeKernel((const void*)fwd_kernel, dim3(grid), dim3(NWAVES * 64), kargs, LDS_BYTES, stream);
    if (e != hipSuccess) fprintf(stderr, "kernel_launch: cooperative launch failed: %s (grid %d)\n", hipGetErrorString(e), grid);
#endif
}
```
